# Optimizing an MI355X kernel written in HIP

```python
import jax, jax.numpy as jnp
from jax import lax
import numpy as np

D_MODEL = 1024
BATCH = 8
SEQ = 4096
DEPTH = 4

N_META = 16
MIX_WIDTH = 2 * D_MODEL
DN_HEAD_DIM = 128
DN_WIDTH = D_MODEL
DN_HEADS = DN_WIDTH // DN_HEAD_DIM
DN_CONV = 4
CHUNK = 64
SC_WIDTH = MIX_WIDTH - DN_WIDTH
SC_CONV = 3
EPS = 1e-6

SPLITS = (
    3 * DN_WIDTH,
    4 * DN_WIDTH,
    4 * DN_WIDTH + DN_HEADS,
    4 * DN_WIDTH + 2 * DN_HEADS,
    4 * DN_WIDTH + 2 * DN_HEADS + SC_WIDTH,
    4 * DN_WIDTH + 2 * DN_HEADS + 2 * SC_WIDTH,
    4 * DN_WIDTH + 2 * DN_HEADS + 3 * SC_WIDTH,
)
IN_COLS = 4 * DN_WIDTH + 2 * DN_HEADS + 4 * SC_WIDTH

kernel_name = "hymba_gdn_shortconv_hybrid"


def rmsnorm(x, gain):
    xf = x.astype(jnp.float32)
    y = xf * lax.rsqrt(jnp.mean(xf * xf, axis=-1, keepdims=True) + EPS)
    return (y * gain.astype(jnp.float32)).astype(x.dtype)


def l2norm(x):
    return x * lax.rsqrt(jnp.sum(x * x, axis=-1, keepdims=True) + EPS)


def causal_dwconv(x, w):
    K = w.shape[0]
    L = x.shape[1]
    xp = jnp.pad(x, ((0, 0), (K - 1, 0), (0, 0)))
    y = xp[:, 0:L, :] * w[0]
    for j in range(1, K):
        y = y + xp[:, j:j + L, :] * w[j]
    return y


def chunk_gated_delta_rule(q, k, v, g, beta):
    Bsz, L, H, dk = q.shape
    dv = v.shape[-1]
    N = L // CHUNK

    def to_chunks(t):
        t = t.reshape((Bsz, N, CHUNK, H) + t.shape[3:])
        return jnp.moveaxis(t, 3, 1)

    q, k, v, g, beta = (to_chunks(t) for t in (q, k, v, g, beta))
    g = jnp.cumsum(g, axis=-1)
    idx = jnp.arange(CHUNK)
    causal = idx[:, None] >= idx[None, :]
    strict = idx[:, None] > idx[None, :]
    decay = jnp.exp(jnp.where(causal, g[..., :, None] - g[..., None, :], -jnp.inf))
    kk = jnp.einsum('bhnid,bhnjd->bhnij', k, k)
    a_low = jnp.where(strict, beta[..., :, None] * kk * decay, 0.0)
    tmat = a_low + jnp.eye(CHUNK, dtype=a_low.dtype)
    u = lax.linalg.triangular_solve(tmat, v * beta[..., None], left_side=True, lower=True, unit_diagonal=True)
    w = lax.linalg.triangular_solve(tmat, k * (beta * jnp.exp(g))[..., None], left_side=True, lower=True, unit_diagonal=True)
    qk = jnp.einsum('bhnid,bhnjd->bhnij', q, k) * decay
    q_dec = q * jnp.exp(g)[..., None]
    g_last = g[..., -1]
    k_dec = k * jnp.exp(g_last[..., None] - g)[..., None]
    xs = tuple(jnp.moveaxis(t, 2, 0) for t in (u, w, qk, q_dec, k_dec, jnp.exp(g_last)))

    def step(S, inp):
        u_c, w_c, qk_c, qd_c, kd_c, gl_c = inp
        v_new = u_c - jnp.einsum('bhcd,bhde->bhce', w_c, S)
        o = jnp.einsum('bhcd,bhde->bhce', qd_c, S) + jnp.einsum('bhij,bhje->bhie', qk_c, v_new)
        S = S * gl_c[..., None, None] + jnp.einsum('bhcd,bhce->bhde', kd_c, v_new)
        return S, o

    S0 = jnp.zeros((Bsz, H, dk, dv), jnp.float32)
    _, o = lax.scan(step, S0, xs)
    o = jnp.moveaxis(o, 0, 2)
    return jnp.moveaxis(o, 1, 3).reshape(Bsz, L, H, dv)


def hybrid_layer(x, norm_g, w_in, dn_conv_w, dn_A_log, dn_dt_bias, dn_out_g, sc_conv_w, w_out):
    Bsz, L, _ = x.shape
    f32 = jnp.float32
    h = rmsnorm(x, norm_g)
    p = h @ w_in
    qkv, dn_z, dn_a, dn_b, sc_b, sc_c, sc_h, sc_z = jnp.split(p, SPLITS, axis=-1)

    qkv = jax.nn.silu(causal_dwconv(qkv, dn_conv_w)).astype(f32)
    q, k, v = jnp.split(qkv, 3, axis=-1)
    q = l2norm(q.reshape(Bsz, L, DN_HEADS, DN_HEAD_DIM)) * (DN_HEAD_DIM ** -0.5)
    k = l2norm(k.reshape(Bsz, L, DN_HEADS, DN_HEAD_DIM))
    v = v.reshape(Bsz, L, DN_HEADS, DN_HEAD_DIM)
    g = -jnp.exp(dn_A_log.astype(f32)) * jax.nn.softplus(dn_a.astype(f32) + dn_dt_bias.astype(f32))
    beta = jax.nn.sigmoid(dn_b.astype(f32))
    pad_front = (-N_META) % CHUNK
    pad_back = (-(pad_front + L)) % CHUNK

    def padt(t):
        return jnp.pad(t, ((0, 0), (pad_front, pad_back)) + ((0, 0),) * (t.ndim - 2))

    o = chunk_gated_delta_rule(padt(q), padt(k), padt(v), padt(g), padt(beta))[:, pad_front:pad_front + L]
    o = rmsnorm(o, dn_out_g) * jax.nn.silu(dn_z.astype(f32).reshape(Bsz, L, DN_HEADS, DN_HEAD_DIM))
    o_dn = o.reshape(Bsz, L, DN_WIDTH).astype(x.dtype)

    y = sc_b * causal_dwconv(sc_c * sc_h, sc_conv_w)
    o_sc = (y * jax.nn.silu(sc_z)).astype(x.dtype)

    mix = jnp.concatenate([o_dn, o_sc], axis=-1)
    return x + mix @ w_out


def setup_inputs(seed: int = 0) -> dict:
    key = jax.random.key(seed)
    ks = jax.random.split(key, 12)
    x = jax.random.normal(ks[0], (BATCH, SEQ, D_MODEL), jnp.float32)
    meta_tokens = jax.random.normal(ks[1], (N_META, D_MODEL), jnp.float32)
    norm_g = 1.0 + 0.02 * jax.random.normal(ks[2], (DEPTH, D_MODEL), jnp.float32)
    w_in = jax.random.normal(ks[3], (DEPTH, D_MODEL, IN_COLS), jnp.float32) * (D_MODEL ** -0.5)
    dn_conv_w = jax.random.normal(ks[4], (DEPTH, DN_CONV, 3 * DN_WIDTH), jnp.float32) * (DN_CONV ** -0.5)
    dn_A_log = jnp.log(jax.random.uniform(ks[5], (DEPTH, DN_HEADS), jnp.float32, 1.0, 16.0))
    dt = jnp.exp(jax.random.uniform(ks[6], (DEPTH, DN_HEADS), jnp.float32, np.log(1e-3), np.log(1e-1)))
    dn_dt_bias = dt + jnp.log(-jnp.expm1(-dt))
    dn_out_g = 1.0 + 0.02 * jax.random.normal(ks[7], (DEPTH, DN_HEAD_DIM), jnp.float32)
    sc_conv_w = jax.random.normal(ks[8], (DEPTH, SC_CONV, SC_WIDTH), jnp.float32) * (SC_CONV ** -0.5)
    w_out = jax.random.normal(ks[9], (DEPTH, MIX_WIDTH, D_MODEL), jnp.float32) * (MIX_WIDTH ** -0.5)
    final_g = 1.0 + 0.02 * jax.random.normal(ks[10], (D_MODEL,), jnp.float32)
    return {"x": x, "meta_tokens": meta_tokens, "norm_g": norm_g, "w_in": w_in,
            "dn_conv_w": dn_conv_w, "dn_A_log": dn_A_log, "dn_dt_bias": dn_dt_bias,
            "dn_out_g": dn_out_g, "sc_conv_w": sc_conv_w, "w_out": w_out, "final_g": final_g}


def reference(x, meta_tokens, norm_g, w_in, dn_conv_w, dn_A_log, dn_dt_bias, dn_out_g, sc_conv_w, w_out, final_g):
    Bsz = x.shape[0]
    meta = jnp.broadcast_to(meta_tokens[None].astype(x.dtype), (Bsz, N_META, D_MODEL))
    h = jnp.concatenate([meta, x], axis=1)
    for l in range(DEPTH):
        h = hybrid_layer(h, norm_g[l], w_in[l], dn_conv_w[l], dn_A_log[l], dn_dt_bias[l],
                         dn_out_g[l], sc_conv_w[l], w_out[l])
    return rmsnorm(h[:, N_META:], final_g)
```

```cpp
#include <hip/hip_runtime.h>
#include <hip/hip_cooperative_groups.h>
#include <cstdio>
namespace cg = cooperative_groups;

#ifndef N_LAUNCH_MODE
#define N_LAUNCH_MODE 0
#endif

#define LAS __attribute__((address_space(3)))
typedef unsigned short bf16_t;
typedef short bf16x8 __attribute__((ext_vector_type(8)));
typedef float f32x4 __attribute__((ext_vector_type(4)));
typedef unsigned u32x4 __attribute__((ext_vector_type(4)));
typedef unsigned u32x2 __attribute__((ext_vector_type(2)));

constexpr int LTOK = 4112, MROWS = 32896, MPAD = 33024, NCH = 65, N1 = 8448, INCOLS = 8208;
constexpr int SEG0 = 33;
constexpr float EPS = 1e-6f;
constexpr int LDS_BYTES = 147456;

constexpr size_t SZ_QKV = (size_t)MROWS * 3072 * 2, SZ_ZG = (size_t)MPAD * 2048 * 2, SZ_U = (size_t)MROWS * 1024 * 2;
constexpr size_t SZ_WIN = (size_t)N1 * 1024 * 2, SZ_WOUT = (size_t)1024 * 2048 * 2, SZ_AB = (size_t)MROWS * 16 * 4;
constexpr size_t SZ_HMETA = (size_t)128 * 1024 * 4, SZ_GLAST = 16896, SZ_SSAVE = (size_t)256 * 512 * 8 * 4;
constexpr size_t SZ_HALO = (size_t)8 * 65 * 3 * 3072 * 2, SZ_X = (size_t)MPAD * 1024 * 2;
constexpr size_t OFF_QKV = 0, OFF_ZG = OFF_QKV + SZ_QKV, OFF_U = OFF_ZG + SZ_ZG, OFF_WIN = OFF_U + SZ_U, OFF_WOUT = OFF_WIN + SZ_WIN;
constexpr size_t OFF_AB = OFF_WOUT + SZ_WOUT, OFF_HMETA = OFF_AB + SZ_AB, OFF_GLAST = OFF_HMETA + SZ_HMETA, OFF_SSAVE = OFF_GLAST + SZ_GLAST;
constexpr size_t OFF_HALO = OFF_SSAVE + SZ_SSAVE, OFF_X = OFF_HALO + SZ_HALO, WS_END = OFF_X + SZ_X;
constexpr size_t OFF_KDT = OFF_X, OFF_PIMG = OFF_X + (size_t)64 * SEG0 * 16384;
static_assert(OFF_PIMG + (size_t)64 * SEG0 * 8192 <= WS_END, "ext images must fit");

struct Params {
    const float *x, *meta, *norm_g, *w_in, *dn_conv_w, *A_log, *dt_bias, *out_g, *sc_conv_w, *w_out, *final_g;
    float* out; unsigned char* ws; int ph_lo, ph_hi;
};

typedef float f32x2 __attribute__((ext_vector_type(2)));
typedef __bf16 bf16x2_n __attribute__((ext_vector_type(2)));
__device__ __forceinline__ unsigned cvt_pk_bf16(float lo, float hi) { f32x2 v = {lo, hi}; bf16x2_n b = __builtin_convertvector(v, bf16x2_n); return __builtin_bit_cast(unsigned, b); }
__device__ __forceinline__ bf16_t f2bf(float f) { unsigned u = __float_as_uint(f); u += 0x7FFFu + ((u >> 16) & 1u); return (bf16_t)(u >> 16); }
__device__ __forceinline__ float bf_lo(unsigned w) { return __uint_as_float(w << 16); }
__device__ __forceinline__ float bf_hi(unsigned w) { return __uint_as_float(w & 0xffff0000u); }
__device__ __forceinline__ float bf2f(bf16_t v) { return __uint_as_float(((unsigned)v) << 16); }
__device__ __forceinline__ float silu_f(float v) { return v / (1.f + __expf(-v)); }
__device__ __forceinline__ int img128_byte(int row, int elem) { return row * 256 + ((((elem >> 3) ^ (row & 15))) << 4) + (elem & 7) * 2; }
__device__ __forceinline__ int img64_byte(int row, int elem) { return row * 128 + ((((elem >> 3) ^ ((row >> 1) & 7))) << 4) + (elem & 7) * 2; }

namespace pg8 {
constexpr int BM = 256, BK = 64, HALF = 128, HTB = HALF * BK * 2, STAGE_BYTES = 8 * HTB, NXCD = 8, WGM = 8;
__device__ __forceinline__ int lds_byte(int r, int c) { const int st = (r >> 4) * 2 + (c >> 5), rr = r & 15, cc = c & 31, ob = rr * 64 + cc * 2; return st * 1024 + (ob ^ (((ob >> 9) & 1) << 5)); }
__device__ __forceinline__ void stage_rc(int b, int& R, int& C) { const int st = b / 1024, sb = b % 1024, swz = sb ^ (((sb >> 9) & 1) << 5); R = (st >> 1) * 16 + swz / 64; C = (st & 1) * 32 + (swz % 64) / 2; }
struct Unit { int pm, pn; };
struct Gemm { const bf16_t* A; const bf16_t* Bt; int M, N, K; };
struct StaticOrder {
    int nM, nN, nwg, G, c;
    __device__ void init(int M, int N, int G_, int c_) { nM = M / BM; nN = N / BM; nwg = nM * nN; G = G_; c = c_; }
    __device__ bool next(int i, Unit& u) const {
        const long L = (long)i * G + c; if (L >= nwg) return false;
        int wgid = (int)L; { const int q = nwg / NXCD, r = nwg % NXCD, xcd = wgid % NXCD, off = wgid / NXCD; wgid = (xcd < r ? xcd * (q + 1) : r * (q + 1) + (xcd - r) * q) + off; }
        const int nig = WGM * nN, gid = wgid / nig, fm = gid * WGM, gsz = (nM - fm) < WGM ? (nM - fm) : WGM;
        u.pm = fm + ((wgid % nig) % gsz); u.pn = (wgid % nig) / gsz; return true;
    }
};

template <class Epi>
__device__ __forceinline__ void gemm_phase(LAS unsigned char* lds, const Gemm g, const StaticOrder& S, const Epi& E) {
    int tid = threadIdx.x; asm volatile("" : "+v"(tid));
    const int wid = __builtin_amdgcn_readfirstlane(tid >> 6), lane = tid & 63, wr = wid >> 2, wc = wid & 3, fr = lane & 15, fq = lane >> 4;
    const int K = g.K, nt = K / BK;
    unsigned voffA[2], voffB[2];
#pragma unroll
    for (int i = 0; i < 2; ++i) { int R, C; stage_rc(tid * 16 + i * 8192, R, C); voffA[i] = (unsigned)(R * K + C) * 2u; voffB[i] = (unsigned)(R * K + C) * 2u; }
    const size_t kstep = (size_t)(BK * 2);
    const size_t hstep = (size_t)HALF * K * 2;
    const size_t tstep = 2 * hstep;
    const unsigned ldsw = (unsigned)wid * 1024u;
    const int aoff = lds_byte(wr * 64 + fr, fq * 8), boff = lds_byte(wc * 32 + fr, fq * 8);
#define PG8_SA(b, h) (((b) * 2 + (h)) * HTB)
#define PG8_SB(b, h) ((4 + (b) * 2 + (h)) * HTB)
#define PG8_STAGE(bufoff, gbase, voff) do { _Pragma("unroll") for (int _i = 0; _i < 2; ++_i) \
        __builtin_amdgcn_global_load_lds((const unsigned*)((const char*)(gbase) + (voff)[_i]), (LAS unsigned*)(lds + (bufoff) + ldsw + _i * 8192), 16, 0, 0); } while (0)
#define PG8_LDA(dst, b, h) do { _Pragma("unroll") for (int m = 0; m < 4; ++m) _Pragma("unroll") for (int k = 0; k < 2; ++k) dst[m][k] = *(const LAS bf16x8*)(lds + PG8_SA(b, h) + aoff + m * 2048 + k * 1024); } while (0)
#define PG8_LDB(dst, b, h) do { _Pragma("unroll") for (int n = 0; n < 2; ++n) _Pragma("unroll") for (int k = 0; k < 2; ++k) dst[n][k] = *(const LAS bf16x8*)(lds + PG8_SB(b, h) + boff + n * 2048 + k * 1024); } while (0)
#define PG8_MMA(ai, bj, At, Bt) do { __builtin_amdgcn_s_setprio(1); _Pragma("unroll") for (int m = 0; m < 4; ++m) _Pragma("unroll") for (int n = 0; n < 2; ++n) _Pragma("unroll") for (int k = 0; k < 2; ++k) \
        acc[ai][bj][m][n] = __builtin_amdgcn_mfma_f32_16x16x32_bf16(Bt[n][k], At[m][k], acc[ai][bj][m][n], 0, 0, 0); __builtin_amdgcn_s_setprio(0); } while (0)
#define PG8_WAIT_V(n) asm volatile("s_waitcnt vmcnt(" #n ")" ::: "memory")
#define PG8_WAIT_L(n) asm volatile("s_waitcnt lgkmcnt(" #n ")" ::: "memory")
#define PG8_BAR __builtin_amdgcn_s_barrier()
#define PG8_SCHED __builtin_amdgcn_sched_barrier(0)
    Unit cur, nxt; int ui = 0;
    if (!S.next(0, cur)) return;
    f32x4 acc[2][2][4][2];
#pragma unroll
    for (int a = 0; a < 2; ++a)
#pragma unroll
        for (int b = 0; b < 2; ++b)
#pragma unroll
            for (int m = 0; m < 4; ++m)
#pragma unroll
                for (int n = 0; n < 2; ++n) acc[a][b][m][n] = (f32x4){0.f, 0.f, 0.f, 0.f};
    bf16x8 At[4][2], B0[2][2], B1[2][2];
    const char* cA = (const char*)g.A + (size_t)cur.pm * tstep; const char* cB = (const char*)g.Bt + (size_t)cur.pn * tstep;
    PG8_STAGE(PG8_SB(0, 0), cB, voffB); PG8_STAGE(PG8_SA(0, 0), cA, voffA); PG8_STAGE(PG8_SB(0, 1), cB + hstep, voffB); PG8_STAGE(PG8_SA(0, 1), cA + hstep, voffA);
    if (wr == 1) PG8_BAR;
    PG8_WAIT_V(4); PG8_BAR;
    PG8_STAGE(PG8_SB(1, 0), cB + kstep, voffB); PG8_STAGE(PG8_SA(1, 0), cA + kstep, voffA); PG8_STAGE(PG8_SB(1, 1), cB + hstep + kstep, voffB);
    PG8_WAIT_V(6); PG8_BAR;
    for (;;) {
        const bool has_next = S.next(ui + 1, nxt);
        const char* nA = has_next ? (const char*)g.A + (size_t)nxt.pm * tstep : cA; const char* nB = has_next ? (const char*)g.Bt + (size_t)nxt.pn * tstep : cB;
        for (int t = 0; t < nt; t += 2) {
            const bool last = (t == nt - 2);
            const char* a1 = cA + (size_t)(t + 1) * kstep;
            const char* a2 = last ? nA : cA + (size_t)(t + 2) * kstep; const char* b2 = last ? nB : cB + (size_t)(t + 2) * kstep;
            const char* a3 = a2 + kstep; const char* b3 = b2 + kstep;
            PG8_LDB(B0, 0, 0); PG8_SCHED; PG8_LDA(At, 0, 0); PG8_STAGE(PG8_SA(1, 1), a1 + hstep, voffA);
            PG8_WAIT_L(8); PG8_BAR; PG8_WAIT_L(0); PG8_MMA(0, 0, At, B0); PG8_BAR; PG8_SCHED;
            PG8_LDB(B1, 0, 1); PG8_STAGE(PG8_SB(0, 0), b2, voffB);
            PG8_BAR; PG8_WAIT_L(0); PG8_MMA(0, 1, At, B1); PG8_BAR;
            PG8_LDA(At, 0, 1); PG8_STAGE(PG8_SA(0, 0), a2, voffA);
            PG8_BAR; PG8_WAIT_L(0); PG8_MMA(1, 0, At, B0); PG8_BAR; PG8_SCHED;
            PG8_STAGE(PG8_SB(0, 1), b2 + hstep, voffB);
            PG8_WAIT_V(6); PG8_BAR; PG8_MMA(1, 1, At, B1); PG8_BAR;
            PG8_LDB(B0, 1, 0); PG8_SCHED; PG8_LDA(At, 1, 0); PG8_STAGE(PG8_SA(0, 1), a2 + hstep, voffA);
            PG8_WAIT_L(8); PG8_BAR; PG8_WAIT_L(0); PG8_MMA(0, 0, At, B0); PG8_BAR; PG8_SCHED;
            PG8_LDB(B1, 1, 1); PG8_STAGE(PG8_SB(1, 0), b3, voffB);
            PG8_BAR; PG8_WAIT_L(0); PG8_MMA(0, 1, At, B1); PG8_BAR;
            PG8_LDA(At, 1, 1); PG8_STAGE(PG8_SA(1, 0), a3, voffA);
            PG8_BAR; PG8_WAIT_L(0); PG8_MMA(1, 0, At, B0); PG8_BAR; PG8_SCHED;
            PG8_STAGE(PG8_SB(1, 1), b3 + hstep, voffB);
            PG8_WAIT_V(6); PG8_BAR; PG8_MMA(1, 1, At, B1); PG8_BAR;
        }
        E(acc, cur, wr, wc, fr, fq);
        if (!has_next) break;
#pragma unroll
        for (int a = 0; a < 2; ++a)
#pragma unroll
            for (int b = 0; b < 2; ++b)
#pragma unroll
                for (int m = 0; m < 4; ++m)
#pragma unroll
                    for (int n = 0; n < 2; ++n) acc[a][b][m][n] = (f32x4){0.f, 0.f, 0.f, 0.f};
        cur = nxt; cA = nA; cB = nB; ++ui;
    }
    PG8_WAIT_V(0);
    if (wr == 0) PG8_BAR;
    PG8_BAR;
#undef PG8_SA
#undef PG8_SB
#undef PG8_STAGE
#undef PG8_LDA
#undef PG8_LDB
#undef PG8_MMA
#undef PG8_WAIT_V
#undef PG8_WAIT_L
#undef PG8_BAR
#undef PG8_SCHED
}
}

struct Epi1 {
    bf16_t* QKV; bf16_t* ZG; bf16_t* U; float* AB; bf16_t* HALO; const float* A_log; const float* dt_bias;
    __device__ __forceinline__ void operator()(const f32x4 (&acc)[2][2][4][2], const pg8::Unit& u, int wr, int wc, int fr, int fq) const {
        const int row0 = u.pm * 256 + wr * 64 + fr;
        if (u.pn < 12) {
#pragma unroll
            for (int ai = 0; ai < 2; ++ai)
#pragma unroll
                for (int m = 0; m < 4; ++m) {
                    const int r = row0 + ai * 128 + m * 16;
                    if (r < MROWS) {
                        const int b = r / LTOK, t = r - b * LTOK, tm = t & 63, cn = (t >> 6) + 1;
                        const bool halo = (tm >= 13) && (tm <= 15) && (cn <= 64);
                        bf16_t* rp = QKV + (size_t)r * 3072 + u.pn * 256 + wc * 32 + fq * 4;
                        bf16_t* hp = HALO + ((size_t)((b * 65 + cn) * 3 + (tm - 13))) * 3072 + u.pn * 256 + wc * 32 + fq * 4;
#pragma unroll
                        for (int bj = 0; bj < 2; ++bj)
#pragma unroll
                            for (int n = 0; n < 2; ++n) {
                                const f32x4 v = acc[ai][bj][m][n];
                                u32x2 pk; pk[0] = cvt_pk_bf16(v[0], v[1]); pk[1] = cvt_pk_bf16(v[2], v[3]);
                                *(u32x2*)(rp + bj * 128 + n * 16) = pk;
                                if (halo) *(u32x2*)(hp + bj * 128 + n * 16) = pk;
                            }
                    }
                }
        } else if (u.pn < 16) {
#pragma unroll
            for (int ai = 0; ai < 2; ++ai)
#pragma unroll
                for (int m = 0; m < 4; ++m) {
                    const int r = row0 + ai * 128 + m * 16;
                    if (r < MROWS) {
                        bf16_t* rp = ZG + (size_t)r * 2048 + (u.pn - 12) * 256 + wc * 32 + fq * 4;
#pragma unroll
                        for (int bj = 0; bj < 2; ++bj)
#pragma unroll
                            for (int n = 0; n < 2; ++n) {
                                const f32x4 v = acc[ai][bj][m][n];
                                u32x2 pk; pk[0] = cvt_pk_bf16(v[0], v[1]); pk[1] = cvt_pk_bf16(v[2], v[3]);
                                *(u32x2*)(rp + bj * 128 + n * 16) = pk;
                            }
                    }
                }
        } else if (u.pn < 32) {
            const int ch = (u.pn - 16) * 64 + wc * 16 + fq * 4;
#pragma unroll
            for (int ai = 0; ai < 2; ++ai)
#pragma unroll
                for (int m = 0; m < 4; ++m) {
                    const int r = row0 + ai * 128 + m * 16;
                    if (r < MROWS) {
                        const f32x4 vb = acc[ai][0][m][0], vc = acc[ai][0][m][1], vh = acc[ai][1][m][0], vz = acc[ai][1][m][1];
                        float uu[4], gg[4];
#pragma unroll
                        for (int e = 0; e < 4; ++e) { uu[e] = vc[e] * vh[e]; gg[e] = vb[e] * silu_f(vz[e]); }
                        u32x2 pu, pg; pu[0] = cvt_pk_bf16(uu[0], uu[1]); pu[1] = cvt_pk_bf16(uu[2], uu[3]); pg[0] = cvt_pk_bf16(gg[0], gg[1]); pg[1] = cvt_pk_bf16(gg[2], gg[3]);
                        *(u32x2*)(U + (size_t)r * 1024 + ch) = pu;
                        *(u32x2*)(ZG + (size_t)r * 2048 + 1024 + ch) = pg;
                    }
                }
        } else {
            if (wc == 0) {
#pragma unroll
                for (int ai = 0; ai < 2; ++ai)
#pragma unroll
                    for (int m = 0; m < 4; ++m) {
                        const int r = row0 + ai * 128 + m * 16;
                        if (r < MROWS) {
                            const f32x4 v = acc[ai][0][m][0];
                            f32x4 o;
#pragma unroll
                            for (int e = 0; e < 4; ++e) {
                                if (fq < 2) { const int hd = 4 * fq + e; const float xx = v[e] + dt_bias[hd]; const float sp = xx > 20.f ? xx : log1pf(__expf(xx)); o[e] = -__expf(A_log[hd]) * sp; }
                                else o[e] = 1.f / (1.f + __expf(-v[e]));
                            }
                            *(f32x4*)(AB + (size_t)r * 16 + 4 * fq) = o;
                        }
                    }
            }
        }
    }
};

struct Epi2 {
    const float* src_real; const float* src_meta; int meta_bstride; float* dst_real; float* dst_meta;
    __device__ __forceinline__ void operator()(const f32x4 (&acc)[2][2][4][2], const pg8::Unit& u, int wr, int wc, int fr, int fq) const {
        const int row0 = u.pm * 256 + wr * 64 + fr, col0 = u.pn * 256 + wc * 32 + 4 * fq;
#pragma unroll
        for (int ai = 0; ai < 2; ++ai)
#pragma unroll
            for (int m = 0; m < 4; ++m) {
                const int r = row0 + ai * 128 + m * 16;
                if (r < MROWS) {
                    const int b = r / LTOK, t = r - b * LTOK;
                    const float* s; float* d;
                    if (t < 16) { s = src_meta + (size_t)(b * meta_bstride + t) * 1024; d = dst_meta + (size_t)(b * 16 + t) * 1024; }
                    else { s = src_real + ((size_t)b * 4096 + (t - 16)) * 1024; d = dst_real + ((size_t)b * 4096 + (t - 16)) * 1024; }
#pragma unroll
                    for (int bj = 0; bj < 2; ++bj)
#pragma unroll
                        for (int n = 0; n < 2; ++n) { const int c = col0 + bj * 128 + n * 16; *(f32x4*)(d + c) = *(const f32x4*)(s + c) + acc[ai][bj][m][n]; }
                }
            }
    }
};

__device__ __forceinline__ int slot_to_col(int s) {
    if (s < 4096) return s;
    if (s < 8192) { const int tl = (s - 4096) >> 8, ci = s & 255, bj = ci >> 7, wc = (ci >> 5) & 3, n = (ci >> 4) & 1, fq = (ci >> 2) & 3, e = ci & 3;
        return 4112 + (bj * 2 + n) * 1024 + tl * 64 + wc * 16 + fq * 4 + e; }
    s -= 8192; return s < 16 ? 4096 + s : -1;
}

__device__ __forceinline__ void phase_prep(const Params& p, int l) {
    int tid = threadIdx.x; asm volatile("" : "+v"(tid));
    const int wid = tid >> 6, lane = tid & 63;
    const int gw = blockIdx.x * 8 + wid, nw = gridDim.x * 8;
    bf16_t* WINT = (bf16_t*)(p.ws + OFF_WIN); bf16_t* WOUTT = (bf16_t*)(p.ws + OFF_WOUT); bf16_t* HN = (bf16_t*)(p.ws + OFF_X);
    for (int wt = gw; wt < 2112 + 512; wt += nw) {
        float v[64];
        bf16_t* dst;
        if (wt < 2112) {
            const int sb = wt >> 4, kb = wt & 15, slot = sb * 64 + lane, oc = slot_to_col(slot);
            const float* src = p.w_in + (size_t)l * 1024 * INCOLS + (size_t)(kb * 64) * INCOLS + (oc < 0 ? 0 : oc);
#pragma unroll
            for (int kk = 0; kk < 64; ++kk) v[kk] = src[(size_t)kk * INCOLS];
            if (oc < 0) {
#pragma unroll
                for (int kk = 0; kk < 64; ++kk) v[kk] = 0.f;
            }
            dst = WINT + (size_t)slot * 1024 + kb * 64;
        } else {
            const int w2 = wt - 2112, nb = w2 >> 5, kb = w2 & 31, n = nb * 64 + lane;
            const float* src = p.w_out + (size_t)l * 2048 * 1024 + (size_t)(kb * 64) * 1024 + n;
#pragma unroll
            for (int kk = 0; kk < 64; ++kk) v[kk] = src[(size_t)kk * 1024];
            dst = WOUTT + (size_t)n * 2048 + kb * 64;
        }
#pragma unroll
        for (int q = 0; q < 8; ++q) {
            u32x4 o; o[0] = cvt_pk_bf16(v[8 * q], v[8 * q + 1]); o[1] = cvt_pk_bf16(v[8 * q + 2], v[8 * q + 3]); o[2] = cvt_pk_bf16(v[8 * q + 4], v[8 * q + 5]); o[3] = cvt_pk_bf16(v[8 * q + 6], v[8 * q + 7]);
            *(u32x4*)(dst + 8 * q) = o;
        }
    }
    const float* gain = p.norm_g + (size_t)l * 1024;
    const float* HM = (const float*)(p.ws + OFF_HMETA);
    for (int r = gw; r < MROWS; r += nw) {
        const int b = r / LTOK, t = r - b * LTOK;
        const float* s;
        if (t < 16) s = (l == 0) ? p.meta + (size_t)t * 1024 : HM + (size_t)(b * 16 + t) * 1024;
        else s = ((l == 0) ? p.x : (const float*)p.out) + ((size_t)b * 4096 + (t - 16)) * 1024;
        f32x4 v[4]; float ss = 0.f;
#pragma unroll
        for (int q = 0; q < 4; ++q) { v[q] = *(const f32x4*)(s + lane * 4 + 256 * q); ss += v[q][0] * v[q][0] + v[q][1] * v[q][1] + v[q][2] * v[q][2] + v[q][3] * v[q][3]; }
#pragma unroll
        for (int o = 32; o >= 1; o >>= 1) ss += __shfl_xor(ss, o);
        const float rstd = rsqrtf(ss * (1.f / 1024.f) + EPS);
#pragma unroll
        for (int q = 0; q < 4; ++q) {
            const f32x4 gq = *(const f32x4*)(gain + lane * 4 + 256 * q);
            u32x2 o; o[0] = cvt_pk_bf16(v[q][0] * rstd * gq[0], v[q][1] * rstd * gq[1]); o[1] = cvt_pk_bf16(v[q][2] * rstd * gq[2], v[q][3] * rstd * gq[3]);
            *(u32x2*)(HN + (size_t)r * 1024 + lane * 4 + 256 * q) = o;
        }
    }
}

__device__ __forceinline__ void stage_a(const Params& p, int l, int seg, LAS unsigned char* lds) {
    bf16_t* QKV = (bf16_t*)(p.ws + OFF_QKV); const bf16_t* HALO = (const bf16_t*)(p.ws + OFF_HALO);
    const float* AB = (const float*)(p.ws + OFF_AB); float* GLAST = (float*)(p.ws + OFF_GLAST);
    LAS float* AM = (LAS float*)(lds); LAS float* RHS = (LAS float*)(lds + 16384); LAS unsigned char* KB = lds + 81920; LAS unsigned char* QB = lds + 98304;
    LAS bf16_t* KDS = (LAS bf16_t*)(lds + 114688); LAS unsigned char* PS = lds + 132096; LAS float* GS = (LAS float*)(lds + 140288); LAS float* BS = (LAS float*)(lds + 140544);
    const int nchunks = seg == 0 ? SEG0 : NCH - SEG0, c_lo = seg == 0 ? 0 : SEG0, ntasks = 64 * nchunks;
    for (int task = blockIdx.x; task < ntasks; task += gridDim.x) {
        int tid = threadIdx.x; asm volatile("" : "+v"(tid));
        const int wid = __builtin_amdgcn_readfirstlane(tid >> 6), lane = tid & 63, fr = lane & 15, fq = lane >> 4;
        const int bh = task / nchunks, cs = task - bh * nchunks, c = c_lo + cs, b = bh >> 3, h = bh & 7;
        const int t0 = 64 * c - 48;
        const long rowbase = (long)b * LTOK + t0;
        if (wid == 0) {
            float g = 0.f, be = 0.f;
            if (t0 + lane >= 0) { const float* ab = AB + (size_t)(rowbase + lane) * 16; g = ab[h]; be = ab[8 + h]; }
#pragma unroll
            for (int off = 1; off < 64; off <<= 1) { const float v = __shfl_up(g, off); if (lane >= off) g += v; }
            GS[lane] = g; BS[lane] = be;
            if (lane == 63) GLAST[bh * 65 + c] = __expf(g);
        }
        __syncthreads();
        const int gidx = tid & 15, rs = tid >> 4;
        float qreg[2][8];
        const float glast = GS[63];
#pragma unroll
        for (int pp = 0; pp < 2; ++pp) {
            const int i = rs + 32 * pp; const bool valid = (t0 + i) >= 0;
            const float Gi = GS[i], bi = BS[i];
            float y[3][8];
#pragma unroll
            for (int part = 0; part < 3; ++part) {
                const int col = part * 1024 + h * 128 + gidx * 8;
                float a[8];
#pragma unroll
                for (int e = 0; e < 8; ++e) a[e] = 0.f;
#pragma unroll
                for (int j = 0; j < 4; ++j) {
                    const int ii = i - 3 + j;
                    u32x4 raw = (u32x4){0u, 0u, 0u, 0u};
                    if (t0 + ii >= 0) {
                        const bf16_t* src = (ii >= 0) ? QKV + (size_t)(rowbase + ii) * 3072 + col : HALO + ((size_t)((b * 65 + c) * 3 + (ii + 3))) * 3072 + col;
                        raw = *(const u32x4*)src;
                    }
                    const float* cw = p.dn_conv_w + ((size_t)l * 4 + j) * 3072 + col;
                    const f32x4 w0 = *(const f32x4*)cw, w1 = *(const f32x4*)(cw + 4);
                    a[0] += w0[0] * bf_lo(raw[0]); a[1] += w0[1] * bf_hi(raw[0]); a[2] += w0[2] * bf_lo(raw[1]); a[3] += w0[3] * bf_hi(raw[1]);
                    a[4] += w1[0] * bf_lo(raw[2]); a[5] += w1[1] * bf_hi(raw[2]); a[6] += w1[2] * bf_lo(raw[3]); a[7] += w1[3] * bf_hi(raw[3]);
                }
#pragma unroll
                for (int e = 0; e < 8; ++e) y[part][e] = valid ? silu_f(a[e]) : 0.f;
            }
            float sq = 0.f, sk = 0.f;
#pragma unroll
            for (int e = 0; e < 8; ++e) { sq += y[0][e] * y[0][e]; sk += y[1][e] * y[1][e]; }
#pragma unroll
            for (int o = 1; o < 16; o <<= 1) { sq += __shfl_xor(sq, o); sk += __shfl_xor(sk, o); }
            const float iq = rsqrtf(sq + EPS) * 0.08838834764831845f, ik = rsqrtf(sk + EPS);
            const float eg = __expf(Gi), egl = __expf(glast - Gi);
            float qv[8], kv[8];
#pragma unroll
            for (int e = 0; e < 8; ++e) { qv[e] = y[0][e] * iq; kv[e] = y[1][e] * ik; qreg[pp][e] = qv[e] * eg; }
            u32x4 pk, pq;
            pk[0] = cvt_pk_bf16(kv[0], kv[1]); pk[1] = cvt_pk_bf16(kv[2], kv[3]); pk[2] = cvt_pk_bf16(kv[4], kv[5]); pk[3] = cvt_pk_bf16(kv[6], kv[7]);
            pq[0] = cvt_pk_bf16(qv[0], qv[1]); pq[1] = cvt_pk_bf16(qv[2], qv[3]); pq[2] = cvt_pk_bf16(qv[4], qv[5]); pq[3] = cvt_pk_bf16(qv[6], qv[7]);
            *(LAS u32x4*)(KB + img128_byte(i, gidx * 8)) = pk;
            *(LAS u32x4*)(QB + img128_byte(i, gidx * 8)) = pq;
            const float bk = bi * eg;
            *(LAS f32x4*)(RHS + i * 256 + gidx * 8) = (f32x4){bi * y[2][0], bi * y[2][1], bi * y[2][2], bi * y[2][3]};
            *(LAS f32x4*)(RHS + i * 256 + gidx * 8 + 4) = (f32x4){bi * y[2][4], bi * y[2][5], bi * y[2][6], bi * y[2][7]};
            *(LAS f32x4*)(RHS + i * 256 + 128 + gidx * 8) = (f32x4){bk * kv[0], bk * kv[1], bk * kv[2], bk * kv[3]};
            *(LAS f32x4*)(RHS + i * 256 + 128 + gidx * 8 + 4) = (f32x4){bk * kv[4], bk * kv[5], bk * kv[6], bk * kv[7]};
            u32x4 pd;
            pd[0] = cvt_pk_bf16(kv[0] * egl, kv[1] * egl); pd[1] = cvt_pk_bf16(kv[2] * egl, kv[3] * egl); pd[2] = cvt_pk_bf16(kv[4] * egl, kv[5] * egl); pd[3] = cvt_pk_bf16(kv[6] * egl, kv[7] * egl);
            *(LAS u32x4*)(KDS + i * 136 + gidx * 8) = pd;
        }
        __syncthreads();
#pragma unroll
        for (int pp = 0; pp < 2; ++pp) {
            const int i = rs + 32 * pp;
            if (t0 + i >= 0) {
                u32x4 o; o[0] = cvt_pk_bf16(qreg[pp][0], qreg[pp][1]); o[1] = cvt_pk_bf16(qreg[pp][2], qreg[pp][3]); o[2] = cvt_pk_bf16(qreg[pp][4], qreg[pp][5]); o[3] = cvt_pk_bf16(qreg[pp][6], qreg[pp][7]);
                *(u32x4*)(QKV + (size_t)(rowbase + i) * 3072 + h * 128 + ((gidx ^ (i & 15)) << 3)) = o;
            }
        }
        {
            unsigned char* kdt = p.ws + OFF_KDT + (size_t)(bh * SEG0 + cs) * 16384;
#pragma unroll
            for (int pp = 0; pp < 2; ++pp) {
                const int id = tid + 512 * pp, dk = id & 127, ic = id >> 7;
                unsigned short e[8];
#pragma unroll
                for (int q = 0; q < 8; ++q) e[q] = KDS[(8 * ic + q) * 136 + dk];
                u32x4 o; o[0] = e[0] | ((unsigned)e[1] << 16); o[1] = e[2] | ((unsigned)e[3] << 16); o[2] = e[4] | ((unsigned)e[5] << 16); o[3] = e[6] | ((unsigned)e[7] << 16);
                *(u32x4*)(kdt + dk * 128 + ((ic ^ ((dk >> 1) & 7)) << 4)) = o;
            }
        }
        {
            const int mat = wid >> 2, rt = wid & 3;
            LAS unsigned char* Ab = mat == 0 ? KB : QB;
            for (int ct = 0; ct < 4; ++ct) {
                f32x4 acc = (f32x4){0.f, 0.f, 0.f, 0.f};
                if (ct <= rt) {
#pragma unroll
                    for (int ks = 0; ks < 4; ++ks) {
                        const bf16x8 af = *(const LAS bf16x8*)(Ab + img128_byte(16 * rt + fr, 32 * ks + 8 * fq));
                        const bf16x8 bf = *(const LAS bf16x8*)(KB + img128_byte(16 * ct + fr, 32 * ks + 8 * fq));
                        acc = __builtin_amdgcn_mfma_f32_16x16x32_bf16(af, bf, acc, 0, 0, 0);
                    }
                }
                const int j = 16 * ct + fr; const float Gj = GS[j];
#pragma unroll
                for (int rg = 0; rg < 4; ++rg) {
                    const int i = 16 * rt + 4 * fq + rg;
                    const float dec = __expf(fminf(GS[i] - Gj, 0.f));
                    if (mat == 0) { if (ct <= rt) AM[i * 64 + j] = (i > j) ? BS[i] * acc[rg] * dec : 0.f; }
                    else *(LAS bf16_t*)(PS + img64_byte(i, j)) = f2bf((i >= j) ? acc[rg] * dec : 0.f);
                }
            }
        }
        __syncthreads();
        if (tid < 256) {
            const int j = tid;
            float x[64];
#pragma unroll
            for (int i = 0; i < 64; ++i) {
                float a0 = RHS[i * 256 + j], a1 = 0.f;
#pragma unroll
                for (int g = 0; g < (i + 3) / 4; ++g) {
                    const f32x4 av = *(const LAS f32x4*)(AM + i * 64 + g * 4);
                    if (4 * g + 0 < i) a0 -= av[0] * x[4 * g + 0];
                    if (4 * g + 1 < i) a1 -= av[1] * x[4 * g + 1];
                    if (4 * g + 2 < i) a0 -= av[2] * x[4 * g + 2];
                    if (4 * g + 3 < i) a1 -= av[3] * x[4 * g + 3];
                }
                x[i] = a0 + a1;
                __builtin_amdgcn_sched_barrier(0);
            }
            const int i_lo = t0 < 0 ? -t0 : 0;
            if (j < 128) {
                size_t off = (size_t)rowbase * 3072 + 2048 + h * 128 + j;
#pragma unroll
                for (int i = 0; i < 64; ++i) { asm volatile("" : "+v"(off)); if (i >= i_lo) QKV[off] = f2bf(x[i]); off += 3072; }
            } else {
                int dk = j - 128;
                size_t off = (size_t)rowbase * 3072 + 1024 + h * 128 + (dk & 7);
#pragma unroll
                for (int i = 0; i < 64; ++i) { asm volatile("" : "+v"(off), "+v"(dk)); if (i >= i_lo) QKV[off + (((dk >> 3) ^ (i & 15)) << 3)] = f2bf(x[i]); off += 3072; }
            }
        } else {
            unsigned char* pim = p.ws + OFF_PIMG + (size_t)(bh * SEG0 + cs) * 8192;
#pragma unroll
            for (int pp = 0; pp < 2; ++pp) { const int id = (tid - 256) + 256 * pp; *(u32x4*)(pim + id * 16) = *(const LAS u32x4*)(PS + id * 16); }
        }
        __syncthreads();
    }
}

__device__ __forceinline__ void stage_b(const Params& p, int seg, LAS unsigned char* lds) {
    int tid = threadIdx.x; asm volatile("" : "+v"(tid));
    const int wid = __builtin_amdgcn_readfirstlane(tid >> 6), lane = tid & 63, fr = lane & 15, fq = lane >> 4;
    bf16_t* QKV = (bf16_t*)(p.ws + OFF_QKV); const float* GLAST = (const float*)(p.ws + OFF_GLAST); float* SSAVE = (float*)(p.ws + OFF_SSAVE);
    LAS unsigned char* WL = lds; LAS unsigned char* QDL = lds + 16384; LAS unsigned char* KDTL = lds + 32768; LAS unsigned char* PL = lds + 49152;
    LAS unsigned char* STL = lds + 57344; LAS unsigned char* VNTL = lds + 65536;
    const int nch = seg == 0 ? SEG0 : NCH - SEG0, c_lo = seg == 0 ? 0 : SEG0;
    for (int wk = blockIdx.x; wk < 256; wk += gridDim.x) {
        const int bh = (wk & 7) + 8 * (wk >> 5), sl = (wk >> 3) & 3, b = bh >> 3, h = bh & 7;
        f32x4 accS[2];
        if (seg == 0) { accS[0] = (f32x4){0.f, 0.f, 0.f, 0.f}; accS[1] = accS[0]; }
        else { accS[0] = *(const f32x4*)(SSAVE + ((size_t)wk * 512 + tid) * 8); accS[1] = *(const f32x4*)(SSAVE + ((size_t)wk * 512 + tid) * 8 + 4); }
#pragma unroll
        for (int ct = 0; ct < 2; ++ct) { u32x2 o; o[0] = cvt_pk_bf16(accS[ct][0], accS[ct][1]); o[1] = cvt_pk_bf16(accS[ct][2], accS[ct][3]); *(LAS u32x2*)(STL + img128_byte(16 * ct + fr, 16 * wid + 4 * fq)) = o; }
        for (int cs = 0; cs < nch; ++cs) {
            const int c = c_lo + cs, t0 = 64 * c - 48;
            const long rowbase = (long)b * LTOK + t0;
            const unsigned char* kdt = p.ws + OFF_KDT + (size_t)(bh * SEG0 + cs) * 16384;
            const unsigned char* pim = p.ws + OFF_PIMG + (size_t)(bh * SEG0 + cs) * 8192;
#pragma unroll
            for (int pp = 0; pp < 2; ++pp) {
                const int id = tid + 512 * pp, i = id >> 4, ch = id & 15;
                u32x4 wv = (u32x4){0u, 0u, 0u, 0u}, qv = wv;
                if (t0 + i >= 0) { const bf16_t* rp = QKV + (size_t)(rowbase + i) * 3072 + h * 128 + ch * 8; qv = *(const u32x4*)rp; wv = *(const u32x4*)(rp + 1024); }
                *(LAS u32x4*)(WL + id * 16) = wv; *(LAS u32x4*)(QDL + id * 16) = qv;
                *(LAS u32x4*)(KDTL + id * 16) = *(const u32x4*)(kdt + id * 16);
            }
            *(LAS u32x4*)(PL + tid * 16) = *(const u32x4*)(pim + tid * 16);
            float uu[2][4];
            if (wid < 4) {
#pragma unroll
                for (int ct = 0; ct < 2; ++ct)
#pragma unroll
                    for (int rg = 0; rg < 4; ++rg) {
                        const int i = 16 * wid + 4 * fq + rg;
                        uu[ct][rg] = (t0 + i >= 0) ? bf2f(QKV[(size_t)(rowbase + i) * 3072 + 2048 + h * 128 + sl * 32 + 16 * ct + fr]) : 0.f;
                    }
            }
            const float gl = GLAST[bh * 65 + c];
            __syncthreads();
            f32x4 accY[2]; accY[0] = (f32x4){0.f, 0.f, 0.f, 0.f}; accY[1] = accY[0];
            {
                LAS unsigned char* Ab = wid < 4 ? WL : QDL; const int arow = 16 * (wid & 3) + fr;
#pragma unroll
                for (int ks = 0; ks < 4; ++ks) {
                    const bf16x8 af = *(const LAS bf16x8*)(Ab + img128_byte(arow, 32 * ks + 8 * fq));
#pragma unroll
                    for (int ct = 0; ct < 2; ++ct) {
                        const bf16x8 bf = *(const LAS bf16x8*)(STL + img128_byte(16 * ct + fr, 32 * ks + 8 * fq));
                        accY[ct] = __builtin_amdgcn_mfma_f32_16x16x32_bf16(af, bf, accY[ct], 0, 0, 0);
                    }
                }
            }
            if (wid < 4) {
#pragma unroll
                for (int ct = 0; ct < 2; ++ct) {
                    u32x2 o; o[0] = cvt_pk_bf16(uu[ct][0] - accY[ct][0], uu[ct][1] - accY[ct][1]); o[1] = cvt_pk_bf16(uu[ct][2] - accY[ct][2], uu[ct][3] - accY[ct][3]);
                    *(LAS u32x2*)(VNTL + img64_byte(16 * ct + fr, 16 * wid + 4 * fq)) = o;
                }
            }
            __syncthreads();
            if (wid >= 4) {
                const int rt = wid - 4;
#pragma unroll
                for (int ks = 0; ks < 2; ++ks) {
                    const bf16x8 af = *(const LAS bf16x8*)(PL + img64_byte(16 * rt + fr, 32 * ks + 8 * fq));
#pragma unroll
                    for (int ct = 0; ct < 2; ++ct) {
                        const bf16x8 bf = *(const LAS bf16x8*)(VNTL + img64_byte(16 * ct + fr, 32 * ks + 8 * fq));
                        accY[ct] = __builtin_amdgcn_mfma_f32_16x16x32_bf16(af, bf, accY[ct], 0, 0, 0);
                    }
                }
#pragma unroll
                for (int ct = 0; ct < 2; ++ct)
#pragma unroll
                    for (int rg = 0; rg < 4; ++rg) {
                        const int i = 16 * rt + 4 * fq + rg;
                        if (t0 + i >= 0) QKV[(size_t)(rowbase + i) * 3072 + 2048 + h * 128 + sl * 32 + 16 * ct + fr] = f2bf(accY[ct][rg]);
                    }
            }
            accS[0] *= gl; accS[1] *= gl;
#pragma unroll
            for (int ks = 0; ks < 2; ++ks) {
                const bf16x8 af = *(const LAS bf16x8*)(KDTL + img64_byte(16 * wid + fr, 32 * ks + 8 * fq));
#pragma unroll
                for (int ct = 0; ct < 2; ++ct) {
                    const bf16x8 bf = *(const LAS bf16x8*)(VNTL + img64_byte(16 * ct + fr, 32 * ks + 8 * fq));
                    accS[ct] = __builtin_amdgcn_mfma_f32_16x16x32_bf16(af, bf, accS[ct], 0, 0, 0);
                }
            }
#pragma unroll
            for (int ct = 0; ct < 2; ++ct) { u32x2 o; o[0] = cvt_pk_bf16(accS[ct][0], accS[ct][1]); o[1] = cvt_pk_bf16(accS[ct][2], accS[ct][3]); *(LAS u32x2*)(STL + img128_byte(16 * ct + fr, 16 * wid + 4 * fq)) = o; }
            __syncthreads();
        }
        if (seg == 0) { *(f32x4*)(SSAVE + ((size_t)wk * 512 + tid) * 8) = accS[0]; *(f32x4*)(SSAVE + ((size_t)wk * 512 + tid) * 8 + 4) = accS[1]; }
    }
}

__device__ __forceinline__ void phase_mix(const Params& p, int l) {
    int tid = threadIdx.x; asm volatile("" : "+v"(tid));
    const int wid = tid >> 6, lane = tid & 63;
    const int gw = blockIdx.x * 8 + wid, nw = gridDim.x * 8;
    const bf16_t* QKV = (const bf16_t*)(p.ws + OFF_QKV); bf16_t* ZG = (bf16_t*)(p.ws + OFF_ZG); const bf16_t* U = (const bf16_t*)(p.ws + OFF_U);
    const float* og = p.out_g + (size_t)l * 128 + (lane & 7) * 16;
    const float* cw = p.sc_conv_w + (size_t)l * 3 * 1024 + lane * 16;
    for (int r = gw; r < MROWS; r += nw) {
        const int b = r / LTOK, t = r - b * LTOK;
        {
            const u32x4 o0 = *(const u32x4*)(QKV + (size_t)r * 3072 + 2048 + lane * 16), o1 = *(const u32x4*)(QKV + (size_t)r * 3072 + 2048 + lane * 16 + 8);
            const u32x4 z0 = *(const u32x4*)(ZG + (size_t)r * 2048 + lane * 16), z1 = *(const u32x4*)(ZG + (size_t)r * 2048 + lane * 16 + 8);
            float o[16], z[16];
#pragma unroll
            for (int q = 0; q < 4; ++q) { o[2 * q] = bf_lo(o0[q]); o[2 * q + 1] = bf_hi(o0[q]); o[8 + 2 * q] = bf_lo(o1[q]); o[8 + 2 * q + 1] = bf_hi(o1[q]);
                z[2 * q] = bf_lo(z0[q]); z[2 * q + 1] = bf_hi(z0[q]); z[8 + 2 * q] = bf_lo(z1[q]); z[8 + 2 * q + 1] = bf_hi(z1[q]); }
            float ss = 0.f;
#pragma unroll
            for (int e = 0; e < 16; ++e) ss += o[e] * o[e];
            ss += __shfl_xor(ss, 1); ss += __shfl_xor(ss, 2); ss += __shfl_xor(ss, 4);
            const float rstd = rsqrtf(ss * (1.f / 128.f) + EPS);
            float y[16];
#pragma unroll
            for (int e = 0; e < 16; ++e) y[e] = o[e] * rstd * og[e] * silu_f(z[e]);
            u32x4 w0, w1;
#pragma unroll
            for (int q = 0; q < 4; ++q) { w0[q] = cvt_pk_bf16(y[2 * q], y[2 * q + 1]); w1[q] = cvt_pk_bf16(y[8 + 2 * q], y[8 + 2 * q + 1]); }
            *(u32x4*)(ZG + (size_t)r * 2048 + lane * 16) = w0; *(u32x4*)(ZG + (size_t)r * 2048 + lane * 16 + 8) = w1;
        }
        {
            float a[16];
#pragma unroll
            for (int e = 0; e < 16; ++e) a[e] = 0.f;
#pragma unroll
            for (int j = 0; j < 3; ++j) {
                if (t - 2 + j >= 0) {
                    const bf16_t* up = U + (size_t)(r - 2 + j) * 1024 + lane * 16;
                    const u32x4 u0 = *(const u32x4*)up, u1 = *(const u32x4*)(up + 8);
#pragma unroll
                    for (int q = 0; q < 4; ++q) {
                        a[2 * q] += cw[j * 1024 + 2 * q] * bf_lo(u0[q]); a[2 * q + 1] += cw[j * 1024 + 2 * q + 1] * bf_hi(u0[q]);
                        a[8 + 2 * q] += cw[j * 1024 + 8 + 2 * q] * bf_lo(u1[q]); a[8 + 2 * q + 1] += cw[j * 1024 + 8 + 2 * q + 1] * bf_hi(u1[q]);
                    }
                }
            }
            bf16_t* gp = ZG + (size_t)r * 2048 + 1024 + lane * 16;
            const u32x4 g0 = *(const u32x4*)gp, g1 = *(const u32x4*)(gp + 8);
            u32x4 w0, w1;
#pragma unroll
            for (int q = 0; q < 4; ++q) { w0[q] = cvt_pk_bf16(a[2 * q] * bf_lo(g0[q]), a[2 * q + 1] * bf_hi(g0[q])); w1[q] = cvt_pk_bf16(a[8 + 2 * q] * bf_lo(g1[q]), a[8 + 2 * q + 1] * bf_hi(g1[q])); }
            *(u32x4*)gp = w0; *(u32x4*)(gp + 8) = w1;
        }
    }
}

__device__ __forceinline__ void phase_final(const Params& p) {
    int tid = threadIdx.x; asm volatile("" : "+v"(tid));
    const int wid = tid >> 6, lane = tid & 63;
    const int gw = blockIdx.x * 8 + wid, nw = gridDim.x * 8;
    for (int r = gw; r < 8 * 4096; r += nw) {
        float* s = p.out + (size_t)r * 1024;
        f32x4 v[4]; float ss = 0.f;
#pragma unroll
        for (int q = 0; q < 4; ++q) { v[q] = *(const f32x4*)(s + lane * 4 + 256 * q); ss += v[q][0] * v[q][0] + v[q][1] * v[q][1] + v[q][2] * v[q][2] + v[q][3] * v[q][3]; }
#pragma unroll
        for (int o = 32; o >= 1; o >>= 1) ss += __shfl_xor(ss, o);
        const float rstd = rsqrtf(ss * (1.f / 1024.f) + EPS);
#pragma unroll
        for (int q = 0; q < 4; ++q) { const f32x4 gq = *(const f32x4*)(p.final_g + lane * 4 + 256 * q); *(f32x4*)(s + lane * 4 + 256 * q) = v[q] * rstd * gq; }
    }
}

constexpr int N_PHASES = 33;
#ifndef PHM
#define PHM 63
#endif

__global__ void __launch_bounds__(512, 2) mega(Params p) {
    extern __shared__ __attribute__((aligned(16))) unsigned char shm[];
    LAS unsigned char* lds = (LAS unsigned char*)shm;
    for (int ph = p.ph_lo; ph < p.ph_hi; ++ph) {
        if (ph > p.ph_lo) cg::this_grid().sync();
        if (ph == 32) { phase_final(p); continue; }
        const int l = ph >> 3, s = ph & 7;
        if (s == 0) { if (PHM & 1) phase_prep(p, l); }
        else if (s == 1) { if (PHM & 2) {
            pg8::Gemm g; g.A = (const bf16_t*)(p.ws + OFF_X); g.Bt = (const bf16_t*)(p.ws + OFF_WIN); g.M = MPAD; g.N = N1; g.K = 1024;
            pg8::StaticOrder S; S.init(MPAD, N1, gridDim.x, blockIdx.x);
            Epi1 E; E.QKV = (bf16_t*)(p.ws + OFF_QKV); E.ZG = (bf16_t*)(p.ws + OFF_ZG); E.U = (bf16_t*)(p.ws + OFF_U); E.AB = (float*)(p.ws + OFF_AB); E.HALO = (bf16_t*)(p.ws + OFF_HALO);
            E.A_log = p.A_log + l * 8; E.dt_bias = p.dt_bias + l * 8;
            pg8::gemm_phase(lds, g, S, E); }
        }
        else if (s == 2 || s == 4) { if (PHM & 4) stage_a(p, l, s == 4 ? 1 : 0, lds); }
        else if (s == 3 || s == 5) { if (PHM & 8) stage_b(p, s == 5 ? 1 : 0, lds); }
        else if (s == 6) { if (PHM & 16) phase_mix(p, l); }
        else if (PHM & 32) {
            pg8::Gemm g; g.A = (const bf16_t*)(p.ws + OFF_ZG); g.Bt = (const bf16_t*)(p.ws + OFF_WOUT); g.M = MPAD; g.N = 1024; g.K = 2048;
            pg8::StaticOrder S; S.init(MPAD, 1024, gridDim.x, blockIdx.x);
            Epi2 E; E.src_real = (l == 0) ? p.x : (const float*)p.out; E.src_meta = (l == 0) ? p.meta : (const float*)(p.ws + OFF_HMETA); E.meta_bstride = (l == 0) ? 0 : 16;
            E.dst_real = p.out; E.dst_meta = (float*)(p.ws + OFF_HMETA);
            pg8::gemm_phase(lds, g, S, E);
        }
    }
}

extern "C" void kernel_launch(void* const* d_in, const int* in_sizes, int n_in, void* d_out, int out_size, void* d_ws, size_t ws_size, hipStream_t stream) {
    static int grid = 0;
    if (grid == 0) {
        if (n_in != 11 || ws_size < WS_END) { fprintf(stderr, "kernel_launch: bad inputs / workspace (%zu < %zu)\n", ws_size, (size_t)WS_END); grid = -1; return; }
        int dev = 0, cus = 0, per_cu = 0;
        hipGetDevice(&dev);
        hipDeviceGetAttribute(&cus, hipDeviceAttributeMultiprocessorCount, dev);
        hipFuncSetAttribute((const void*)mega, hipFuncAttributeMaxDynamicSharedMemorySize, LDS_BYTES);
        hipOccupancyMaxActiveBlocksPerMultiprocessor(&per_cu, (const void*)mega, 512, LDS_BYTES);
        if (per_cu < 1) per_cu = 1;
        if (per_cu > 1) per_cu = 1;
        grid = cus * per_cu;
        (void)hipGetLastError();
    }
    if (grid < 0) return;
    Params p{};
    p.x = (const float*)d_in[0]; p.meta = (const float*)d_in[1]; p.norm_g = (const float*)d_in[2]; p.w_in = (const float*)d_in[3]; p.dn_conv_w = (const float*)d_in[4];
    p.A_log = (const float*)d_in[5]; p.dt_bias = (const float*)d_in[6]; p.out_g = (const float*)d_in[7]; p.sc_conv_w = (const float*)d_in[8]; p.w_out = (const float*)d_in[9]; p.final_g = (const float*)d_in[10];
    p.out = (float*)d_out; p.ws = (unsigned char*)d_ws;
#if N_LAUNCH_MODE == 1
    for (int ph = 0; ph < N_PHASES; ++ph) {
        p.ph_lo = ph; p.ph_hi = ph + 1;
        hipLaunchKernelGGL(mega, dim3(grid), dim3(512), LDS_BYTES, stream, p);
    }
#else
    p.ph_lo = 0; p.ph_hi = N_PHASES;
    void* args[] = {&p};
    hipError_t e = hipLaunchCooperativeKernel((const void*)mega, dim3(grid), dim3(512), args, LDS_BYTES, stream);
    if (e != hipSuccess) fprintf(stderr, "cooperative launch failed: %s (grid %d)\n", hipGetErrorString(e), grid);
#endif
}
```

```cpp
#include <hip/hip_runtime.h>
#include <hip/hip_cooperative_groups.h>
#include <cstdio>
namespace cg = cooperative_groups;

#ifndef N_LAUNCH_MODE
#define N_LAUNCH_MODE 0
#endif

#define LAS __attribute__((address_space(3)))
typedef unsigned short bf16_t;
typedef short bf16x8 __attribute__((ext_vector_type(8)));
typedef float f32x4 __attribute__((ext_vector_type(4)));
typedef unsigned u32x4 __attribute__((ext_vector_type(4)));
typedef unsigned u32x2 __attribute__((ext_vector_type(2)));

constexpr int LTOK = 4112, MROWS = 32896, MPAD = 33024, NCH = 65, N1 = 8448, INCOLS = 8208;
constexpr int SEG0 = 33;
constexpr float EPS = 1e-6f;
constexpr int LDS_BYTES = 147456;

constexpr size_t SZ_QKV = (size_t)MROWS * 3072 * 2, SZ_ZG = (size_t)MPAD * 2048 * 2, SZ_U = (size_t)MROWS * 1024 * 2;
constexpr size_t SZ_WIN = (size_t)N1 * 1024 * 2, SZ_WOUT = (size_t)1024 * 2048 * 2, SZ_AB = (size_t)MROWS * 16 * 4;
constexpr size_t SZ_HMETA = (size_t)128 * 1024 * 4, SZ_GLAST = 16896, SZ_SSAVE = (size_t)256 * 512 * 8 * 4;
constexpr size_t SZ_HALO = (size_t)8 * 65 * 3 * 3072 * 2, SZ_X = (size_t)MPAD * 1024 * 2;
constexpr size_t OFF_QKV = 0, OFF_ZG = OFF_QKV + SZ_QKV, OFF_U = OFF_ZG + SZ_ZG, OFF_WIN = OFF_U + SZ_U, OFF_WOUT = OFF_WIN + SZ_WIN;
constexpr size_t OFF_AB = OFF_WOUT + SZ_WOUT, OFF_HMETA = OFF_AB + SZ_AB, OFF_GLAST = OFF_HMETA + SZ_HMETA, OFF_SSAVE = OFF_GLAST + SZ_GLAST;
constexpr size_t OFF_HALO = OFF_SSAVE + SZ_SSAVE, OFF_X = OFF_HALO + SZ_HALO, WS_END = OFF_X + SZ_X;
constexpr size_t OFF_BAR = WS_END, WS_END2 = WS_END + 16384;
constexpr size_t OFF_KDT = OFF_X, OFF_PIMG = OFF_X + (size_t)64 * SEG0 * 16384;
static_assert(OFF_PIMG + (size_t)64 * SEG0 * 8192 <= WS_END, "ext images must fit");

struct Params {
    const float *x, *meta, *norm_g, *w_in, *dn_conv_w, *A_log, *dt_bias, *out_g, *sc_conv_w, *w_out, *final_g;
    float* out; unsigned char* ws; int ph_lo, ph_hi;
};

typedef float f32x2 __attribute__((ext_vector_type(2)));
typedef __bf16 bf16x2_n __attribute__((ext_vector_type(2)));
__device__ __forceinline__ unsigned cvt_pk_bf16(float lo, float hi) { f32x2 v = {lo, hi}; bf16x2_n b = __builtin_convertvector(v, bf16x2_n); return __builtin_bit_cast(unsigned, b); }
__device__ __forceinline__ bf16_t f2bf(float f) { unsigned u = __float_as_uint(f); u += 0x7FFFu + ((u >> 16) & 1u); return (bf16_t)(u >> 16); }
__device__ __forceinline__ float bf_lo(unsigned w) { return __uint_as_float(w << 16); }
__device__ __forceinline__ float bf_hi(unsigned w) { return __uint_as_float(w & 0xffff0000u); }
__device__ __forceinline__ float bf2f(bf16_t v) { return __uint_as_float(((unsigned)v) << 16); }
__device__ __forceinline__ float silu_f(float v) { return v * __builtin_amdgcn_rcpf(1.f + __expf(-v)); }
__device__ __forceinline__ float dpp_shr1(float v) { float r; asm volatile("s_nop 1\n\tv_mov_b32_dpp %0, %1 row_shr:1 row_mask:0xf bank_mask:0xf bound_ctrl:1" : "=v"(r) : "v"(v)); return r; }
__device__ __forceinline__ float dpp_shr2(float v) { float r; asm volatile("s_nop 1\n\tv_mov_b32_dpp %0, %1 row_shr:2 row_mask:0xf bank_mask:0xf bound_ctrl:1" : "=v"(r) : "v"(v)); return r; }
__device__ __forceinline__ float dpp_ror1(float v) { float r; asm volatile("s_nop 1\n\tv_mov_b32_dpp %0, %1 row_ror:1 row_mask:0xf bank_mask:0xf bound_ctrl:1" : "=v"(r) : "v"(v)); return r; }
__device__ __forceinline__ float dpp_ror2(float v) { float r; asm volatile("s_nop 1\n\tv_mov_b32_dpp %0, %1 row_ror:2 row_mask:0xf bank_mask:0xf bound_ctrl:1" : "=v"(r) : "v"(v)); return r; }
__device__ __forceinline__ int img128_byte(int row, int elem) { return row * 256 + ((((elem >> 3) ^ (row & 15))) << 4) + (elem & 7) * 2; }
__device__ __forceinline__ int img64_byte(int row, int elem) { return row * 128 + ((((elem >> 3) ^ ((row >> 1) & 7))) << 4) + (elem & 7) * 2; }

namespace pg8 {
constexpr int BM = 256, BK = 64, HALF = 128, HTB = HALF * BK * 2, STAGE_BYTES = 8 * HTB, NXCD = 8, WGM = 8;
__device__ __forceinline__ int lds_byte(int r, int c) { const int st = (r >> 4) * 2 + (c >> 5), rr = r & 15, cc = c & 31, ob = rr * 64 + cc * 2; return st * 1024 + (ob ^ (((ob >> 9) & 1) << 5)); }
__device__ __forceinline__ void stage_rc(int b, int& R, int& C) { const int st = b / 1024, sb = b % 1024, swz = sb ^ (((sb >> 9) & 1) << 5); R = (st >> 1) * 16 + swz / 64; C = (st & 1) * 32 + (swz % 64) / 2; }
struct Unit { int pm, pn, k0, nt; };
struct Gemm { const bf16_t* A; const bf16_t* Bt; int M, N, K; };
template <bool TAIL> struct StaticOrder {
    int nM, nN, nwg, G, c, ntk;
    __device__ __forceinline__ void init(int M, int N, int K, int G_, int c_) { nM = M / BM; nN = N / BM; nwg = nM * nN; G = G_; c = c_; ntk = K / BK; }
    __device__ __forceinline__ bool next(int i, Unit& u) const {
        const long L = (long)i * G + c;
        if (L >= nwg + (TAIL ? 4 * nN : 0)) return false;
        int pm, pn, k0, nt;
        if (TAIL && L >= nwg) { const int idx = (int)(L - nwg); pm = nM; pn = idx % nN; nt = ntk / 4; k0 = (idx / nN) * (ntk / 4) * BK; }
        else {
            int wgid = (int)L; { const int q = nwg / NXCD, r = nwg % NXCD, xcd = wgid % NXCD, off = wgid / NXCD; wgid = (xcd < r ? xcd * (q + 1) : r * (q + 1) + (xcd - r) * q) + off; }
            const int nig = WGM * nN, gid = wgid / nig, fm = gid * WGM, gsz = (nM - fm) < WGM ? (nM - fm) : WGM;
            pm = fm + ((wgid % nig) % gsz); pn = (wgid % nig) / gsz; k0 = 0; nt = ntk;
        }
        u.pm = pm; u.pn = pn; u.k0 = k0; u.nt = nt; return true;
    }
};

template <class Epi, class Sched>
__device__ __forceinline__ void gemm_phase(LAS unsigned char* lds, const Gemm g, const Sched& S, const Epi& E) {
    int tid = threadIdx.x; asm volatile("" : "+v"(tid));
    const int wid = __builtin_amdgcn_readfirstlane(tid >> 6), lane = tid & 63, wr = wid >> 2, wc = wid & 3, fr = lane & 15, fq = lane >> 4;
    const int K = g.K;
    unsigned voffA[2], voffB[2];
#pragma unroll
    for (int i = 0; i < 2; ++i) { int R, C; stage_rc(tid * 16 + i * 8192, R, C); voffA[i] = (unsigned)(R * K + C) * 2u; voffB[i] = (unsigned)(R * K + C) * 2u; }
    const size_t kstep = (size_t)(BK * 2);
    const size_t hstep = (size_t)HALF * K * 2;
    const size_t tstep = 2 * hstep;
    const unsigned ldsw = (unsigned)wid * 1024u;
    const int aoff = lds_byte(wr * 64 + fr, fq * 8), boff = lds_byte(wc * 32 + fr, fq * 8);
#define PG8_SA(b, h) (((b) * 2 + (h)) * HTB)
#define PG8_SB(b, h) ((4 + (b) * 2 + (h)) * HTB)
#define PG8_STAGE(bufoff, gbase, voff) do { _Pragma("unroll") for (int _i = 0; _i < 2; ++_i) \
        __builtin_amdgcn_global_load_lds((const unsigned*)((const char*)(gbase) + (voff)[_i]), (LAS unsigned*)(lds + (bufoff) + ldsw + _i * 8192), 16, 0, 0); } while (0)
#define PG8_LDA(dst, b, h) do { _Pragma("unroll") for (int m = 0; m < 4; ++m) _Pragma("unroll") for (int k = 0; k < 2; ++k) dst[m][k] = *(const LAS bf16x8*)(lds + PG8_SA(b, h) + aoff + m * 2048 + k * 1024); } while (0)
#define PG8_LDB(dst, b, h) do { _Pragma("unroll") for (int n = 0; n < 2; ++n) _Pragma("unroll") for (int k = 0; k < 2; ++k) dst[n][k] = *(const LAS bf16x8*)(lds + PG8_SB(b, h) + boff + n * 2048 + k * 1024); } while (0)
#define PG8_MMA(ai, bj, At, Bt) do { __builtin_amdgcn_s_setprio(1); _Pragma("unroll") for (int m = 0; m < 4; ++m) _Pragma("unroll") for (int n = 0; n < 2; ++n) _Pragma("unroll") for (int k = 0; k < 2; ++k) \
        acc[ai][bj][m][n] = __builtin_amdgcn_mfma_f32_16x16x32_bf16(Bt[n][k], At[m][k], acc[ai][bj][m][n], 0, 0, 0); __builtin_amdgcn_s_setprio(0); } while (0)
#define PG8_WAIT_V(n) asm volatile("s_waitcnt vmcnt(" #n ")" ::: "memory")
#define PG8_WAIT_L(n) asm volatile("s_waitcnt lgkmcnt(" #n ")" ::: "memory")
#define PG8_BAR __builtin_amdgcn_s_barrier()
#define PG8_SCHED __builtin_amdgcn_sched_barrier(0)
    Unit cur, nxt; int ui = 0;
    if (!S.next(0, cur)) return;
    f32x4 acc[2][2][4][2];
#pragma unroll
    for (int a = 0; a < 2; ++a)
#pragma unroll
        for (int b = 0; b < 2; ++b)
#pragma unroll
            for (int m = 0; m < 4; ++m)
#pragma unroll
                for (int n = 0; n < 2; ++n) acc[a][b][m][n] = (f32x4){0.f, 0.f, 0.f, 0.f};
    bf16x8 At[4][2], B0[2][2], B1[2][2];
    const char* cA = (const char*)g.A + (size_t)cur.pm * tstep + (size_t)cur.k0 * 2; const char* cB = (const char*)g.Bt + (size_t)cur.pn * tstep + (size_t)cur.k0 * 2;
    PG8_STAGE(PG8_SB(0, 0), cB, voffB); PG8_STAGE(PG8_SA(0, 0), cA, voffA); PG8_STAGE(PG8_SB(0, 1), cB + hstep, voffB); PG8_STAGE(PG8_SA(0, 1), cA + hstep, voffA);
    if (wr == 1) PG8_BAR;
    PG8_WAIT_V(4); PG8_BAR;
    PG8_STAGE(PG8_SB(1, 0), cB + kstep, voffB); PG8_STAGE(PG8_SA(1, 0), cA + kstep, voffA); PG8_STAGE(PG8_SB(1, 1), cB + hstep + kstep, voffB);
    PG8_WAIT_V(6); PG8_BAR;
    for (;;) {
        const bool has_next = S.next(ui + 1, nxt);
        const char* nA = has_next ? (const char*)g.A + (size_t)nxt.pm * tstep + (size_t)nxt.k0 * 2 : cA; const char* nB = has_next ? (const char*)g.Bt + (size_t)nxt.pn * tstep + (size_t)nxt.k0 * 2 : cB;
        const int nt = cur.nt;
        for (int t = 0; t < nt; t += 2) {
            const bool last = (t == nt - 2);
            const char* a1 = cA + (size_t)(t + 1) * kstep;
            const char* a2 = last ? nA : cA + (size_t)(t + 2) * kstep; const char* b2 = last ? nB : cB + (size_t)(t + 2) * kstep;
            const char* a3 = a2 + kstep; const char* b3 = b2 + kstep;
            PG8_LDB(B0, 0, 0); PG8_SCHED; PG8_LDA(At, 0, 0); PG8_STAGE(PG8_SA(1, 1), a1 + hstep, voffA);
            PG8_WAIT_L(8); PG8_BAR; PG8_WAIT_L(0); PG8_MMA(0, 0, At, B0); PG8_BAR; PG8_SCHED;
            PG8_LDB(B1, 0, 1); PG8_STAGE(PG8_SB(0, 0), b2, voffB);
            PG8_BAR; PG8_WAIT_L(0); PG8_MMA(0, 1, At, B1); PG8_BAR;
            PG8_LDA(At, 0, 1); PG8_STAGE(PG8_SA(0, 0), a2, voffA);
            PG8_BAR; PG8_WAIT_L(0); PG8_MMA(1, 0, At, B0); PG8_BAR; PG8_SCHED;
            PG8_STAGE(PG8_SB(0, 1), b2 + hstep, voffB);
            PG8_WAIT_V(6); PG8_BAR; PG8_MMA(1, 1, At, B1); PG8_BAR;
            PG8_LDB(B0, 1, 0); PG8_SCHED; PG8_LDA(At, 1, 0); PG8_STAGE(PG8_SA(0, 1), a2 + hstep, voffA);
            PG8_WAIT_L(8); PG8_BAR; PG8_WAIT_L(0); PG8_MMA(0, 0, At, B0); PG8_BAR; PG8_SCHED;
            PG8_LDB(B1, 1, 1); PG8_STAGE(PG8_SB(1, 0), b3, voffB);
            PG8_BAR; PG8_WAIT_L(0); PG8_MMA(0, 1, At, B1); PG8_BAR;
            PG8_LDA(At, 1, 1); PG8_STAGE(PG8_SA(1, 0), a3, voffA);
            PG8_BAR; PG8_WAIT_L(0); PG8_MMA(1, 0, At, B0); PG8_BAR; PG8_SCHED;
            PG8_STAGE(PG8_SB(1, 1), b3 + hstep, voffB);
            PG8_WAIT_V(6); PG8_BAR; PG8_MMA(1, 1, At, B1); PG8_BAR;
        }
        E(acc, cur, wr, wc, fr, fq);
        if (!has_next) break;
#pragma unroll
        for (int a = 0; a < 2; ++a)
#pragma unroll
            for (int b = 0; b < 2; ++b)
#pragma unroll
                for (int m = 0; m < 4; ++m)
#pragma unroll
                    for (int n = 0; n < 2; ++n) acc[a][b][m][n] = (f32x4){0.f, 0.f, 0.f, 0.f};
        cur = nxt; cA = nA; cB = nB; ++ui;
    }
    PG8_WAIT_V(0);
    if (wr == 0) PG8_BAR;
    PG8_BAR;
#undef PG8_SA
#undef PG8_SB
#undef PG8_STAGE
#undef PG8_LDA
#undef PG8_LDB
#undef PG8_MMA
#undef PG8_WAIT_V
#undef PG8_WAIT_L
#undef PG8_BAR
#undef PG8_SCHED
}
}

struct Epi1 {
    bf16_t* QKV; bf16_t* ZG; bf16_t* U; float* AB; bf16_t* HALO; const float* A_log; const float* dt_bias; const float* scw;
    __device__ __forceinline__ void operator()(const f32x4 (&acc)[2][2][4][2], const pg8::Unit& u, int wr, int wc, int fr, int fq) const {
        const int row0 = u.pm * 256 + wr * 64 + fr;
        if (u.pn < 12) {
#pragma unroll
            for (int ai = 0; ai < 2; ++ai)
#pragma unroll
                for (int m = 0; m < 4; ++m) {
                    const int r = row0 + ai * 128 + m * 16;
                    if (r < MROWS) {
                        const int b = r / LTOK, t = r - b * LTOK, tm = t & 63, cn = (t >> 6) + 1;
                        const bool halo = (tm >= 13) && (tm <= 15) && (cn <= 64);
                        bf16_t* rp = QKV + (size_t)r * 3072 + u.pn * 256 + wc * 32 + fq * 8;
                        bf16_t* hp = HALO + ((size_t)((b * 65 + cn) * 3 + (tm - 13))) * 3072 + u.pn * 256 + wc * 32 + fq * 8;
#pragma unroll
                        for (int bj = 0; bj < 2; ++bj) {
                            const f32x4 v0 = acc[ai][bj][m][0], v1 = acc[ai][bj][m][1];
                            u32x4 pk; pk[0] = cvt_pk_bf16(v0[0], v0[1]); pk[1] = cvt_pk_bf16(v0[2], v0[3]); pk[2] = cvt_pk_bf16(v1[0], v1[1]); pk[3] = cvt_pk_bf16(v1[2], v1[3]);
                            *(u32x4*)(rp + bj * 128) = pk;
                            if (halo) *(u32x4*)(hp + bj * 128) = pk;
                        }
                    }
                }
        } else if (u.pn < 16) {
#pragma unroll
            for (int ai = 0; ai < 2; ++ai)
#pragma unroll
                for (int m = 0; m < 4; ++m) {
                    const int r = row0 + ai * 128 + m * 16;
                    if (r < MROWS) {
                        bf16_t* rp = ZG + (size_t)r * 2048 + (u.pn - 12) * 256 + wc * 32 + fq * 8;
#pragma unroll
                        for (int bj = 0; bj < 2; ++bj) {
                            const f32x4 v0 = acc[ai][bj][m][0], v1 = acc[ai][bj][m][1];
                            u32x4 pk; pk[0] = cvt_pk_bf16(v0[0], v0[1]); pk[1] = cvt_pk_bf16(v0[2], v0[3]); pk[2] = cvt_pk_bf16(v1[0], v1[1]); pk[3] = cvt_pk_bf16(v1[2], v1[3]);
                            *(u32x4*)(rp + bj * 128) = pk;
                        }
                    }
                }
        } else if (u.pn < 32) {
            const int ch = (u.pn - 16) * 64 + wc * 16 + fq * 4;
            const f32x4 cw0 = *(const f32x4*)(scw + ch), cw1 = *(const f32x4*)(scw + 1024 + ch), cw2 = *(const f32x4*)(scw + 2048 + ch);
            bf16_t* UH = U; bf16_t* GH = U + (size_t)2 * 1024 * 1024;
#pragma unroll
            for (int ai = 0; ai < 2; ++ai) {
                f32x4 uprev = (f32x4){0.f, 0.f, 0.f, 0.f};
#pragma unroll
                for (int m = 0; m < 4; ++m) {
                    const int r = row0 + ai * 128 + m * 16;
                    const f32x4 vb = acc[ai][0][m][0], vc = acc[ai][0][m][1], vh = acc[ai][1][m][0], vz = acc[ai][1][m][1];
                    f32x4 uu, gg, yy;
#pragma unroll
                    for (int e = 0; e < 4; ++e) { uu[e] = vc[e] * vh[e]; gg[e] = vb[e] * silu_f(vz[e]); }
                    const int b = r / LTOK, t = r - b * LTOK;
#pragma unroll
                    for (int e = 0; e < 4; ++e) {
                        const float s1 = dpp_shr1(uu[e]), s2 = dpp_shr2(uu[e]), r1 = dpp_ror1(uprev[e]), r2 = dpp_ror2(uprev[e]);
                        float p1 = fr >= 1 ? s1 : r1, p2 = fr >= 2 ? s2 : r2;
                        if (t < 1) p1 = 0.f;
                        if (t < 2) p2 = 0.f;
                        yy[e] = gg[e] * (cw0[e] * p2 + cw1[e] * p1 + cw2[e] * uu[e]);
                    }
                    if (r < MROWS) {
                        u32x2 py; py[0] = cvt_pk_bf16(yy[0], yy[1]); py[1] = cvt_pk_bf16(yy[2], yy[3]);
                        *(u32x2*)(ZG + (size_t)r * 2048 + 1024 + ch) = py;
                        if (m == 3 && fr >= 14) { u32x2 pu; pu[0] = cvt_pk_bf16(uu[0], uu[1]); pu[1] = cvt_pk_bf16(uu[2], uu[3]); *(u32x2*)(UH + ((size_t)(r >> 6) * 2 + (fr - 14)) * 1024 + ch) = pu; }
                        if (m == 0 && fr <= 1) { u32x2 pg; pg[0] = cvt_pk_bf16(gg[0], gg[1]); pg[1] = cvt_pk_bf16(gg[2], gg[3]); *(u32x2*)(GH + ((size_t)(r >> 6) * 2 + fr) * 1024 + ch) = pg; }
                    }
                    uprev = uu;
                }
            }
        } else {
            if (wc == 0) {
#pragma unroll
                for (int ai = 0; ai < 2; ++ai)
#pragma unroll
                    for (int m = 0; m < 4; ++m) {
                        const int r = row0 + ai * 128 + m * 16;
                        if (r < MROWS) {
                            const f32x4 v = acc[ai][0][m][0];
                            f32x4 o;
#pragma unroll
                            for (int e = 0; e < 4; ++e) {
                                if (fq < 2) { const int hd = 4 * fq + e; const float xx = v[e] + dt_bias[hd]; const float sp = xx > 20.f ? xx : log1pf(__expf(xx)); o[e] = -__expf(A_log[hd]) * sp; }
                                else o[e] = 1.f / (1.f + __expf(-v[e]));
                            }
                            *(f32x4*)(AB + (size_t)r * 16 + 4 * fq) = o;
                        }
                    }
            }
        }
    }
};

struct Epi2 {
    const float* src_real; const float* src_meta; int meta_bstride; float* dst_real; float* dst_meta;
    __device__ __forceinline__ void operator()(const f32x4 (&acc)[2][2][4][2], const pg8::Unit& u, int wr, int wc, int fr, int fq) const {
        const int row0 = u.pm * 256 + wr * 64 + fr, col0 = u.pn * 256 + wc * 32 + 4 * fq;
        if (u.k0 != 0 || u.nt != 32) {
#pragma unroll
            for (int ai = 0; ai < 2; ++ai)
#pragma unroll
                for (int m = 0; m < 4; ++m) {
                    const int r = row0 + ai * 128 + m * 16;
                    if (r < MROWS) {
                        const int b = r / LTOK, t = r - b * LTOK;
                        float* d = (t < 16) ? dst_meta + (size_t)(b * 16 + t) * 1024 : dst_real + ((size_t)b * 4096 + (t - 16)) * 1024;
#pragma unroll
                        for (int bj = 0; bj < 2; ++bj)
#pragma unroll
                            for (int n = 0; n < 2; ++n)
#pragma unroll
                                for (int e = 0; e < 4; ++e) (void)__builtin_amdgcn_global_atomic_fadd_f32((__attribute__((address_space(1))) float*)(d + col0 + bj * 128 + n * 16 + e), acc[ai][bj][m][n][e]);
                    }
                }
            return;
        }
#pragma unroll
        for (int ai = 0; ai < 2; ++ai) {
            f32x4 res[4][2][2]; float* dp[4];
#pragma unroll
            for (int m = 0; m < 4; ++m) {
                int r = row0 + ai * 128 + m * 16; if (r >= MROWS) r = MROWS - 1;
                const int b = r / LTOK, t = r - b * LTOK;
                const float* s;
                if (t < 16) { s = src_meta + (size_t)(b * meta_bstride + t) * 1024; dp[m] = dst_meta + (size_t)(b * 16 + t) * 1024; }
                else { s = src_real + ((size_t)b * 4096 + (t - 16)) * 1024; dp[m] = dst_real + ((size_t)b * 4096 + (t - 16)) * 1024; }
#pragma unroll
                for (int bj = 0; bj < 2; ++bj)
#pragma unroll
                    for (int n = 0; n < 2; ++n) res[m][bj][n] = *(const f32x4*)(s + col0 + bj * 128 + n * 16);
            }
            __builtin_amdgcn_sched_barrier(0);
#pragma unroll
            for (int m = 0; m < 4; ++m) {
                const int r = row0 + ai * 128 + m * 16;
                if (r < MROWS) {
#pragma unroll
                    for (int bj = 0; bj < 2; ++bj)
#pragma unroll
                        for (int n = 0; n < 2; ++n) *(f32x4*)(dp[m] + col0 + bj * 128 + n * 16) = res[m][bj][n] + acc[ai][bj][m][n];
                }
            }
            __builtin_amdgcn_sched_barrier(0);
        }
    }
};

__device__ __forceinline__ int slot_to_col(int s) {
    if (s < 4096) { const int n = (s >> 4) & 1, fq = (s >> 2) & 3, e = s & 3; return (s & ~31) + 8 * fq + 4 * n + e; }
    if (s < 8192) { const int tl = (s - 4096) >> 8, ci = s & 255, bj = ci >> 7, wc = (ci >> 5) & 3, n = (ci >> 4) & 1, fq = (ci >> 2) & 3, e = ci & 3;
        return 4112 + (bj * 2 + n) * 1024 + tl * 64 + wc * 16 + fq * 4 + e; }
    s -= 8192; return s < 16 ? 4096 + s : -1;
}

__device__ __forceinline__ void phase_prep(const Params& p, int l) {
    int tid = threadIdx.x; asm volatile("" : "+v"(tid));
    const int wid = tid >> 6, lane = tid & 63;
    const int gw = blockIdx.x * 8 + wid, nw = gridDim.x * 8;
    bf16_t* WINT = (bf16_t*)(p.ws + OFF_WIN); bf16_t* WOUTT = (bf16_t*)(p.ws + OFF_WOUT); bf16_t* HN = (bf16_t*)(p.ws + OFF_X);
    for (int wt = gw; wt < 2112 + 512; wt += nw) {
        float v[64];
        bf16_t* dst;
        if (wt < 2112) {
            const int sb = wt >> 4, kb = wt & 15, slot = sb * 64 + lane, oc = slot_to_col(slot);
            const float* src = p.w_in + (size_t)l * 1024 * INCOLS + (size_t)(kb * 64) * INCOLS + (oc < 0 ? 0 : oc);
#pragma unroll
            for (int kk = 0; kk < 64; ++kk) v[kk] = src[(size_t)kk * INCOLS];
            if (oc < 0) {
#pragma unroll
                for (int kk = 0; kk < 64; ++kk) v[kk] = 0.f;
            }
            dst = WINT + (size_t)slot * 1024 + kb * 64;
        } else {
            const int w2 = wt - 2112, nb = w2 >> 5, kb = w2 & 31, n = nb * 64 + lane;
            const float* src = p.w_out + (size_t)l * 2048 * 1024 + (size_t)(kb * 64) * 1024 + n;
#pragma unroll
            for (int kk = 0; kk < 64; ++kk) v[kk] = src[(size_t)kk * 1024];
            dst = WOUTT + (size_t)n * 2048 + kb * 64;
        }
#pragma unroll
        for (int q = 0; q < 8; ++q) {
            u32x4 o; o[0] = cvt_pk_bf16(v[8 * q], v[8 * q + 1]); o[1] = cvt_pk_bf16(v[8 * q + 2], v[8 * q + 3]); o[2] = cvt_pk_bf16(v[8 * q + 4], v[8 * q + 5]); o[3] = cvt_pk_bf16(v[8 * q + 6], v[8 * q + 7]);
            *(u32x4*)(dst + 8 * q) = o;
        }
    }
    if (l == 0) {
        const int gi = blockIdx.x * 512 + tid;
        if (gi < 32768) *(f32x4*)(p.out + (size_t)32640 * 1024 + (size_t)gi * 4) = *(const f32x4*)(p.x + (size_t)32640 * 1024 + (size_t)gi * 4);
    }
    const float* gain = p.norm_g + (size_t)l * 1024;
    const float* HM = (const float*)(p.ws + OFF_HMETA);
    f32x4 gq[4];
#pragma unroll
    for (int q = 0; q < 4; ++q) gq[q] = *(const f32x4*)(gain + lane * 4 + 256 * q);
    for (int rb = gw * 4; rb < MROWS; rb += nw * 4) {
        f32x4 v[4][4];
#pragma unroll
        for (int k = 0; k < 4; ++k) {
            const int r = rb + k, b = r / LTOK, t = r - b * LTOK;
            const float* s;
            if (t < 16) s = (l == 0) ? p.meta + (size_t)t * 1024 : HM + (size_t)(b * 16 + t) * 1024;
            else s = ((l == 0) ? p.x : (const float*)p.out) + ((size_t)b * 4096 + (t - 16)) * 1024;
#pragma unroll
            for (int q = 0; q < 4; ++q) v[k][q] = *(const f32x4*)(s + lane * 4 + 256 * q);
        }
#pragma unroll
        for (int k = 0; k < 4; ++k) {
            float ss = 0.f;
#pragma unroll
            for (int q = 0; q < 4; ++q) ss += v[k][q][0] * v[k][q][0] + v[k][q][1] * v[k][q][1] + v[k][q][2] * v[k][q][2] + v[k][q][3] * v[k][q][3];
#pragma unroll
            for (int o = 32; o >= 1; o >>= 1) ss += __shfl_xor(ss, o);
            const float rstd = rsqrtf(ss * (1.f / 1024.f) + EPS);
#pragma unroll
            for (int q = 0; q < 4; ++q) {
                u32x2 o; o[0] = cvt_pk_bf16(v[k][q][0] * rstd * gq[q][0], v[k][q][1] * rstd * gq[q][1]); o[1] = cvt_pk_bf16(v[k][q][2] * rstd * gq[q][2], v[k][q][3] * rstd * gq[q][3]);
                *(u32x2*)(HN + (size_t)(rb + k) * 1024 + lane * 4 + 256 * q) = o;
            }
        }
    }
}

__device__ __forceinline__ void stage_a(const Params& p, int l, int seg, LAS unsigned char* lds, const bool dry = false, const int bid = blockIdx.x) {
    bf16_t* QKV = (bf16_t*)(p.ws + OFF_QKV); const bf16_t* HALO = (const bf16_t*)(p.ws + OFF_HALO);
    const float* AB = (const float*)(p.ws + OFF_AB); float* GLAST = (float*)(p.ws + OFF_GLAST);
    LAS float* AM = (LAS float*)(lds); LAS unsigned char* KB = lds + 81920; LAS unsigned char* QB = lds + 98304;
    LAS unsigned char* RT = lds + 16384; LAS unsigned char* OUTS = lds + 49152; LAS unsigned char* XI = lds + 81920;
    LAS bf16_t* KDS = (LAS bf16_t*)(lds + 114688); LAS unsigned char* PS = lds + 132096; LAS float* GS = (LAS float*)(lds + 140288); LAS float* BS = (LAS float*)(lds + 140544);
    const int nchunks = seg == 0 ? SEG0 : NCH - SEG0, c_lo = seg == 0 ? 0 : SEG0, ntasks = 64 * nchunks;
    LAS float* CW = (LAS float*)(lds + 140800);
    int h_loaded = -1;
    for (int task = bid; task < ntasks; task += gridDim.x) {
        int tid = threadIdx.x; asm volatile("" : "+v"(tid));
        const int wid = __builtin_amdgcn_readfirstlane(tid >> 6), lane = tid & 63, fr = lane & 15, fq = lane >> 4;
        const int bh = task & 63, cs = task >> 6, c = c_lo + cs, b = bh >> 3, h = bh & 7;
        const int t0 = 64 * c - 48;
        const long rowbase = (long)b * LTOK + t0;
        const int gidx = tid & 15, rs = tid >> 4;
        const bool okl = (t0 + lane) >= 0;
        const float* ab = AB + (size_t)(okl ? rowbase + lane : (long)b * LTOK) * 16;
        const float g0 = ab[h], b0 = ab[8 + h];
        u32x4 raw[3][5]; float mk[5];
#pragma unroll
        for (int r5 = 0; r5 < 5; ++r5) {
            const int ii = 2 * rs - 3 + r5;
            const bool okr = (t0 + ii) >= 0;
            mk[r5] = okr ? 1.f : 0.f;
            const bf16_t* src = (ii >= 0) ? QKV + (size_t)(okr ? rowbase + ii : (long)b * LTOK) * 3072 + h * 128 + gidx * 8 : HALO + ((size_t)((b * 65 + c) * 3 + (ii + 3))) * 3072 + h * 128 + gidx * 8;
#pragma unroll
            for (int part = 0; part < 3; ++part) raw[part][r5] = *(const u32x4*)(src + part * 1024);
        }
        if (c == 0) {
#pragma unroll
            for (int r5 = 0; r5 < 5; ++r5)
#pragma unroll
                for (int part = 0; part < 3; ++part) if (mk[r5] == 0.f) raw[part][r5] = (u32x4){0u, 0u, 0u, 0u};
        }
        if (h != h_loaded) {
#pragma unroll
            for (int q = 0; q < 3; ++q) { const int n = tid + 512 * q, part = n >> 9, j = (n >> 7) & 3, cc = n & 127; CW[n] = p.dn_conv_w[((size_t)l * 4 + j) * 3072 + part * 1024 + h * 128 + cc]; }
            h_loaded = h;
            __syncthreads();
        }
        float gsc = okl ? g0 : 0.f, bsc = okl ? b0 : 0.f;
#pragma unroll
        for (int off = 1; off < 64; off <<= 1) { const float v = __shfl_up(gsc, off); if (lane >= off) gsc += v; }
        if (wid == 0) {
            GS[lane] = gsc; BS[lane] = bsc;
            if (lane == 63 && !dry) GLAST[bh * 65 + c] = __expf(gsc);
        }
        float qreg[2][8], rv[2][8], rk[2][8];
        const float glast = __shfl(gsc, 63);
#pragma unroll
        for (int pp = 0; pp < 2; ++pp) {
            const int i = 2 * rs + pp; const bool valid = (t0 + i) >= 0;
            const float Gi = __shfl(gsc, i), bi = __shfl(bsc, i);
            float y[3][8];
#pragma unroll
            for (int part = 0; part < 3; ++part) {
                const int col = part * 1024 + h * 128 + gidx * 8;
                float a[8];
#pragma unroll
                for (int e = 0; e < 8; ++e) a[e] = 0.f;
#pragma unroll
                for (int j = 0; j < 4; ++j) {
                    const u32x4 rw = raw[part][pp + j];
                    const LAS float* cw = CW + (part * 4 + j) * 128 + gidx * 8;
                    const f32x4 w0 = *(const LAS f32x4*)cw, w1 = *(const LAS f32x4*)(cw + 4);
                    a[0] += w0[0] * bf_lo(rw[0]); a[1] += w0[1] * bf_hi(rw[0]); a[2] += w0[2] * bf_lo(rw[1]); a[3] += w0[3] * bf_hi(rw[1]);
                    a[4] += w1[0] * bf_lo(rw[2]); a[5] += w1[1] * bf_hi(rw[2]); a[6] += w1[2] * bf_lo(rw[3]); a[7] += w1[3] * bf_hi(rw[3]);
                }
#pragma unroll
                for (int e = 0; e < 8; ++e) y[part][e] = valid ? silu_f(a[e]) : 0.f;

            }
            float sq = 0.f, sk = 0.f;
#pragma unroll
            for (int e = 0; e < 8; ++e) { sq += y[0][e] * y[0][e]; sk += y[1][e] * y[1][e]; }
#pragma unroll
            for (int o = 1; o < 16; o <<= 1) { sq += __shfl_xor(sq, o); sk += __shfl_xor(sk, o); }
            const float iq = rsqrtf(sq + EPS) * 0.08838834764831845f, ik = rsqrtf(sk + EPS);
            const float eg = __expf(Gi), egl = __expf(glast - Gi);
            float qv[8], kv[8];
#pragma unroll
            for (int e = 0; e < 8; ++e) { qv[e] = y[0][e] * iq; kv[e] = y[1][e] * ik; qreg[pp][e] = qv[e] * eg; }
            u32x4 pk, pq;
            pk[0] = cvt_pk_bf16(kv[0], kv[1]); pk[1] = cvt_pk_bf16(kv[2], kv[3]); pk[2] = cvt_pk_bf16(kv[4], kv[5]); pk[3] = cvt_pk_bf16(kv[6], kv[7]);
            pq[0] = cvt_pk_bf16(qv[0], qv[1]); pq[1] = cvt_pk_bf16(qv[2], qv[3]); pq[2] = cvt_pk_bf16(qv[4], qv[5]); pq[3] = cvt_pk_bf16(qv[6], qv[7]);
            *(LAS u32x4*)(KB + img128_byte(i, gidx * 8)) = pk;
            *(LAS u32x4*)(QB + img128_byte(i, gidx * 8)) = pq;
            const float bk = bi * eg;
#pragma unroll
            for (int e = 0; e < 8; ++e) { rv[pp][e] = bi * y[2][e]; rk[pp][e] = bk * kv[e]; }
            u32x4 pd;
            pd[0] = cvt_pk_bf16(kv[0] * egl, kv[1] * egl); pd[1] = cvt_pk_bf16(kv[2] * egl, kv[3] * egl); pd[2] = cvt_pk_bf16(kv[4] * egl, kv[5] * egl); pd[3] = cvt_pk_bf16(kv[6] * egl, kv[7] * egl);
            *(LAS u32x4*)(KDS + i * 136 + gidx * 8) = pd;
        }
#pragma unroll
        for (int e = 0; e < 8; ++e) {
            const int jv = gidx * 8 + e;
            *(LAS unsigned*)(RT + img64_byte(jv, 2 * rs)) = cvt_pk_bf16(rv[0][e], rv[1][e]);
            *(LAS unsigned*)(RT + img64_byte(128 + jv, 2 * rs)) = cvt_pk_bf16(rk[0][e], rk[1][e]);
        }
        __syncthreads();
#pragma unroll
        for (int pp = 0; pp < 2; ++pp) {
            const int i = 2 * rs + pp;
            if (t0 + i >= 0 && !dry) {
                u32x4 o; o[0] = cvt_pk_bf16(qreg[pp][0], qreg[pp][1]); o[1] = cvt_pk_bf16(qreg[pp][2], qreg[pp][3]); o[2] = cvt_pk_bf16(qreg[pp][4], qreg[pp][5]); o[3] = cvt_pk_bf16(qreg[pp][6], qreg[pp][7]);
                *(u32x4*)(QKV + (size_t)(rowbase + i) * 3072 + h * 128 + ((gidx ^ (i & 15)) << 3)) = o;
            }
        }
        {
#pragma unroll
            for (int k3 = 0; k3 < 3; ++k3) {
                const int idx = wid + 8 * k3;
                if (idx < 20) {
                    const int mat = idx >= 10 ? 1 : 0, k = idx - 10 * mat;
                    const int rt = (k >= 6) ? 3 : (k >= 3) ? 2 : (k >= 1) ? 1 : 0, ct = k - rt * (rt + 1) / 2;
                    LAS unsigned char* Ab = mat == 0 ? KB : QB;
                    f32x4 acc = (f32x4){0.f, 0.f, 0.f, 0.f};
#pragma unroll
                    for (int ks = 0; ks < 4; ++ks) {
                        const bf16x8 af = *(const LAS bf16x8*)(Ab + img128_byte(16 * rt + fr, 32 * ks + 8 * fq));
                        const bf16x8 bf = *(const LAS bf16x8*)(KB + img128_byte(16 * ct + fr, 32 * ks + 8 * fq));
                        acc = __builtin_amdgcn_mfma_f32_16x16x32_bf16(af, bf, acc, 0, 0, 0);
                    }
                    const int j = 16 * ct + fr; const float Gj = GS[j];
#pragma unroll
                    for (int rg = 0; rg < 4; ++rg) {
                        const int i = 16 * rt + 4 * fq + rg;
                        const float dec = __expf(fminf(GS[i] - Gj, 0.f));
                        if (mat == 0) {
                            const float av_ = (i > j) ? BS[i] * acc[rg] * dec : 0.f;
                            AM[i * 64 + j] = av_;
                            if (rt >= 2 && ct < 2) *(LAS bf16_t*)(OUTS + (i - 32) * 64 + j * 2) = f2bf(av_);
                        }
                        else *(LAS bf16_t*)(PS + img64_byte(i, j)) = f2bf((i >= j) ? acc[rg] * dec : 0.f);
                    }
                }
            }
            if (wid < 6) {
                const int rt = (wid < 3) ? 0 : (wid < 5) ? 1 : 2, ct = (wid < 3) ? wid + 1 : (wid < 5) ? wid - 1 : 3;
                const int j = 16 * ct + fr;
#pragma unroll
                for (int rg = 0; rg < 4; ++rg) *(LAS bf16_t*)(PS + img64_byte(16 * rt + 4 * fq + rg, j)) = (bf16_t)0;
            }
        }
        __syncthreads();
        if (wid == 0) {
            const int hi = lane >> 5, cl = lane & 31;
            const LAS float* Ab = AM + hi * (32 * 64 + 32);
            LAS unsigned char* A21I = OUTS; LAS unsigned char* XT11 = OUTS + 2048; LAS unsigned char* YT = OUTS + 4096;
            f32x2 xp[16];
            f32x4 abuf[2][8];
            abuf[1][0] = *(const LAS f32x4*)(Ab + 64);
#pragma unroll
            for (int i = 0; i < 32; ++i) {
                if (i + 1 < 32 && i + 1 >= 2) {
#pragma unroll
                    for (int g = 0; g < (i + 1 + 3) / 4; ++g) abuf[(i + 1) & 1][g] = *(const LAS f32x4*)(Ab + (i + 1) * 64 + g * 4);
                }
                __builtin_amdgcn_sched_barrier(0);
                f32x2 a0 = (f32x2){0.f, 0.f}, a1 = (f32x2){0.f, 0.f}; float tl = 0.f;
#pragma unroll
                for (int g = 0; g < (i + 3) / 4; ++g) {
                    const f32x4 av = abuf[i & 1][g];
                    if (4 * g + 1 < i) a0 += (f32x2){av[0], av[1]} * xp[2 * g];
                    else if (4 * g < i) tl += av[0] * xp[2 * g][0];
                    if (4 * g + 3 < i) a1 += (f32x2){av[2], av[3]} * xp[2 * g + 1];
                    else if (4 * g + 2 < i) tl += av[2] * xp[2 * g + 1][0];
                }
                float xi = ((i == cl) ? 1.f : 0.f) - (((a0[0] + a0[1]) + (a1[0] + a1[1])) + tl);
                asm volatile("" : "+v"(xi));
                if (i & 1) xp[i >> 1][1] = xi; else { xp[i >> 1][0] = xi; xp[i >> 1][1] = 0.f; }
                __builtin_amdgcn_sched_barrier(0);
            }
#pragma unroll
            for (int i = 0; i < 32; ++i) {
                int lo = lane; asm volatile("" : "+v"(lo));
                *(LAS bf16_t*)(XI + img64_byte(32 * (lo >> 5) + i, lo)) = f2bf(xp[i >> 1][i & 1]);
                if (lo >> 5) *(LAS bf16_t*)(XI + img64_byte(i, lo)) = (bf16_t)0;
            }
            if (!hi) {
#pragma unroll
                for (int q = 0; q < 16; ++q) *(LAS unsigned*)(XT11 + cl * 64 + q * 4) = cvt_pk_bf16(xp[q][0], xp[q][1]);
            }
#pragma unroll
            for (int rtp = 0; rtp < 2; ++rtp)
#pragma unroll
                for (int ctp = 0; ctp < 2; ++ctp) {
                    const bf16x8 afr = *(const LAS bf16x8*)(A21I + (16 * rtp + fr) * 64 + fq * 16);
                    const bf16x8 bfr2 = *(const LAS bf16x8*)(XT11 + (16 * ctp + fr) * 64 + fq * 16);
                    const f32x4 yv = __builtin_amdgcn_mfma_f32_16x16x32_bf16(afr, bfr2, (f32x4){0.f, 0.f, 0.f, 0.f}, 0, 0, 0);
                    u32x2 o; o[0] = cvt_pk_bf16(yv[0], yv[1]); o[1] = cvt_pk_bf16(yv[2], yv[3]);
                    *(LAS u32x2*)(YT + (16 * ctp + fr) * 64 + (16 * rtp + 4 * fq) * 2) = o;
                }
#pragma unroll
            for (int rtp = 0; rtp < 2; ++rtp)
#pragma unroll
                for (int ctp = 0; ctp < 2; ++ctp) {
                    const bf16x8 afr = *(const LAS bf16x8*)(XI + img64_byte(32 + 16 * rtp + fr, 32 + 8 * fq));
                    const bf16x8 bfr2 = *(const LAS bf16x8*)(YT + (16 * ctp + fr) * 64 + fq * 16);
                    const f32x4 xv = __builtin_amdgcn_mfma_f32_16x16x32_bf16(afr, bfr2, (f32x4){0.f, 0.f, 0.f, 0.f}, 0, 0, 0);
#pragma unroll
                    for (int rg = 0; rg < 4; ++rg) *(LAS bf16_t*)(XI + img64_byte(32 + 16 * rtp + 4 * fq + rg, 16 * ctp + fr)) = f2bf(-xv[rg]);
                }
        } else {
            unsigned char* kdt = p.ws + OFF_KDT + (size_t)(bh * SEG0 + cs) * 16384;
#pragma unroll
            for (int pp = 0; pp < 3; ++pp) {
                const int id = (tid - 64) + 448 * pp;
                if (id < 1024) {
                    const int dk = id & 127, ic = id >> 7;
                    unsigned short e[8];
#pragma unroll
                    for (int q = 0; q < 8; ++q) e[q] = KDS[(8 * ic + q) * 136 + dk];
                    u32x4 o; o[0] = e[0] | ((unsigned)e[1] << 16); o[1] = e[2] | ((unsigned)e[3] << 16); o[2] = e[4] | ((unsigned)e[5] << 16); o[3] = e[6] | ((unsigned)e[7] << 16);
                    if (!dry) *(u32x4*)(kdt + dk * 128 + ((ic ^ ((dk >> 1) & 7)) << 4)) = o;
                }
            }
            if (tid >= 256) {
                unsigned char* pim = p.ws + OFF_PIMG + (size_t)(bh * SEG0 + cs) * 8192;
#pragma unroll
                for (int pp = 0; pp < 2; ++pp) { const int id = (tid - 256) + 256 * pp; if (!dry) *(u32x4*)(pim + id * 16) = *(const LAS u32x4*)(PS + id * 16); }
            }
        }
        __syncthreads();
        {
            bf16x8 af[4][2], bfr[2][2];
#pragma unroll
            for (int rt = 0; rt < 4; ++rt)
#pragma unroll
                for (int ks = 0; ks < 2; ++ks) af[rt][ks] = *(const LAS bf16x8*)(XI + img64_byte(16 * rt + fr, 32 * ks + 8 * fq));
#pragma unroll
            for (int jj = 0; jj < 2; ++jj)
#pragma unroll
                for (int ks = 0; ks < 2; ++ks) bfr[jj][ks] = *(const LAS bf16x8*)(RT + img64_byte(16 * (2 * wid + jj) + fr, 32 * ks + 8 * fq));
#pragma unroll
            for (int rt = 0; rt < 4; ++rt)
#pragma unroll
                for (int jj = 0; jj < 2; ++jj) {
                    f32x4 acc = (f32x4){0.f, 0.f, 0.f, 0.f};
#pragma unroll
                    for (int ks = 0; ks < 2; ++ks) acc = __builtin_amdgcn_mfma_f32_16x16x32_bf16(af[rt][ks], bfr[jj][ks], acc, 0, 0, 0);
                    const int jc = 16 * (2 * wid + jj) + fr;
#pragma unroll
                    for (int rg = 0; rg < 4; ++rg) *(LAS bf16_t*)(OUTS + (16 * rt + 4 * fq + rg) * 512 + jc * 2) = f2bf(acc[rg]);
                }
        }
        __syncthreads();
        {
            const int i_lo = dry ? 64 : (t0 < 0 ? -t0 : 0);
#pragma unroll
            for (int q = 0; q < 4; ++q) {
                const int id = tid + 512 * q, half = id >> 10, rem = id & 1023, i = rem >> 4, ch = rem & 15;
                const u32x4 o = *(const LAS u32x4*)(OUTS + i * 512 + half * 256 + ch * 16);
                if (i >= i_lo) *(u32x4*)(QKV + (size_t)(rowbase + i) * 3072 + (half ? 1024 : 2048) + h * 128 + ((half ? (ch ^ (i & 15)) : ch) << 3)) = o;
            }
        }
        __syncthreads();
    }
}

struct BRegs { bf16x8 ay[4], ap[2], ak[2]; unsigned u[2][4]; float gl; };
__device__ __forceinline__ void stage_b(const Params& p, int seg, LAS unsigned char* lds, const bool dry = false, const int bid = blockIdx.x) {
    int tid = threadIdx.x; asm volatile("" : "+v"(tid));
    const int wid = __builtin_amdgcn_readfirstlane(tid >> 6), lane = tid & 63, fr = lane & 15, fq = lane >> 4;
    bf16_t* QKV = (bf16_t*)(p.ws + OFF_QKV); const float* GLAST = (const float*)(p.ws + OFF_GLAST); float* SSAVE = (float*)(p.ws + OFF_SSAVE);
    LAS unsigned char* STL = lds; LAS unsigned char* VNTL = lds + 8192;
    const int nch = seg == 0 ? SEG0 : NCH - SEG0, c_lo = seg == 0 ? 0 : SEG0;
    const bf16x8 zero8 = (bf16x8){0, 0, 0, 0, 0, 0, 0, 0};
    for (int wk = bid; wk < 256; wk += gridDim.x) {
        const int bh = (wk & 7) + 8 * (wk >> 5), sl = (wk >> 3) & 3, b = bh >> 3, h = bh & 7;
        f32x4 accS[2];
        if (seg == 0) { accS[0] = (f32x4){0.f, 0.f, 0.f, 0.f}; accS[1] = accS[0]; }
        else { accS[0] = *(const f32x4*)(SSAVE + ((size_t)wk * 512 + tid) * 8); accS[1] = *(const f32x4*)(SSAVE + ((size_t)wk * 512 + tid) * 8 + 4); }
#pragma unroll
        for (int ct = 0; ct < 2; ++ct) { u32x2 o; o[0] = cvt_pk_bf16(accS[ct][0], accS[ct][1]); o[1] = cvt_pk_bf16(accS[ct][2], accS[ct][3]); *(LAS u32x2*)(STL + img128_byte(16 * ct + fr, 16 * wid + 4 * fq)) = o; }
        const int yrow = 16 * (wid & 3) + fr;
        auto issue_y = [&](int cs_, BRegs& R) {
            {
                const int cs = cs_ < nch ? cs_ : nch - 1;
                const int c = c_lo + cs, t0 = 64 * c - 48;
                const long rowbase = (long)b * LTOK + t0;
                const bool valid = t0 + yrow >= 0;
                const bf16_t* rp = QKV + (size_t)(valid ? rowbase + yrow : (long)b * LTOK) * 3072 + (wid < 4 ? 1024 : 0) + h * 128;
#pragma unroll
                for (int ks = 0; ks < 4; ++ks) R.ay[ks] = *(const bf16x8*)(rp + (((4 * ks + fq) ^ (yrow & 15)) << 3));
                if (wid < 4) {
#pragma unroll
                    for (int ct = 0; ct < 2; ++ct)
#pragma unroll
                        for (int rg = 0; rg < 4; ++rg) {
                            const int i = 16 * wid + 4 * fq + rg;
                            const bool okr = (t0 + i) >= 0;
                            R.u[ct][rg] = QKV[(size_t)(okr ? rowbase + i : (long)b * LTOK) * 3072 + 2048 + h * 128 + sl * 32 + 16 * ct + fr];
                        }
                }
                R.gl = GLAST[bh * 65 + c];
            }
        };
        auto issue_rest = [&](int cs_, BRegs& R) {
            {
                const int cs = cs_ < nch ? cs_ : nch - 1;
                const unsigned char* kdt = p.ws + OFF_KDT + (size_t)(bh * SEG0 + cs) * 16384;
                const unsigned char* pim = p.ws + OFF_PIMG + (size_t)(bh * SEG0 + cs) * 8192;
                const int dk = 16 * wid + fr;
#pragma unroll
                for (int ks = 0; ks < 2; ++ks) R.ak[ks] = *(const bf16x8*)(kdt + dk * 128 + (((4 * ks + fq) ^ ((dk >> 1) & 7)) << 4));
                if (wid >= 4) {
                    const int pi = 16 * (wid - 4) + fr;
#pragma unroll
                    for (int ks = 0; ks < 2; ++ks) R.ap[ks] = *(const bf16x8*)(pim + pi * 128 + (((4 * ks + fq) ^ ((pi >> 1) & 7)) << 4));
                }
            }
        };
        auto body = [&](int cs, BRegs& R) {
            const int c = c_lo + cs, t0 = 64 * c - 48;
            const long rowbase = (long)b * LTOK + t0;
            float uu[2][4];
#pragma unroll
            for (int ct = 0; ct < 2; ++ct)
#pragma unroll
                for (int rg = 0; rg < 4; ++rg) uu[ct][rg] = (t0 + 16 * wid + 4 * fq + rg >= 0) ? __uint_as_float(R.u[ct][rg] << 16) : 0.f;
            const bool yvalid = t0 + yrow >= 0;
            const float gl = R.gl;
            asm volatile("s_waitcnt lgkmcnt(0)" ::: "memory"); __builtin_amdgcn_s_barrier(); asm volatile("" ::: "memory");
            f32x4 accY[2]; accY[0] = (f32x4){0.f, 0.f, 0.f, 0.f}; accY[1] = accY[0];
            bf16x8 bfy[4][2];
#pragma unroll
            for (int ks = 0; ks < 4; ++ks)
#pragma unroll
                for (int ct = 0; ct < 2; ++ct) bfy[ks][ct] = *(const LAS bf16x8*)(STL + img128_byte(16 * ct + fr, 32 * ks + 8 * fq));
#pragma unroll
            for (int ks = 0; ks < 4; ++ks) {
#pragma unroll
                for (int ct = 0; ct < 2; ++ct) accY[ct] = __builtin_amdgcn_mfma_f32_16x16x32_bf16(yvalid ? R.ay[ks] : zero8, bfy[ks][ct], accY[ct], 0, 0, 0);
            }
            if (wid < 4) {
#pragma unroll
                for (int ct = 0; ct < 2; ++ct) {
                    u32x2 o; o[0] = cvt_pk_bf16(uu[ct][0] - accY[ct][0], uu[ct][1] - accY[ct][1]); o[1] = cvt_pk_bf16(uu[ct][2] - accY[ct][2], uu[ct][3] - accY[ct][3]);
                    *(LAS u32x2*)(VNTL + img64_byte(16 * ct + fr, 16 * wid + 4 * fq)) = o;
                }
            }
            issue_y(cs + 2, R);
            asm volatile("s_waitcnt lgkmcnt(0)" ::: "memory"); __builtin_amdgcn_s_barrier(); asm volatile("" ::: "memory");
            bf16x8 bfv[2][2];
#pragma unroll
            for (int ks = 0; ks < 2; ++ks)
#pragma unroll
                for (int ct = 0; ct < 2; ++ct) bfv[ks][ct] = *(const LAS bf16x8*)(VNTL + img64_byte(16 * ct + fr, 32 * ks + 8 * fq));
            if (wid >= 4) {
                const int rt = wid - 4;
#pragma unroll
                for (int ks = 0; ks < 2; ++ks) {
#pragma unroll
                    for (int ct = 0; ct < 2; ++ct) accY[ct] = __builtin_amdgcn_mfma_f32_16x16x32_bf16(R.ap[ks], bfv[ks][ct], accY[ct], 0, 0, 0);
                }
#pragma unroll
                for (int ct = 0; ct < 2; ++ct)
#pragma unroll
                    for (int rg = 0; rg < 4; ++rg) {
                        const int i = 16 * rt + 4 * fq + rg;
                        if (t0 + i >= 0 && !dry) QKV[(size_t)(rowbase + i) * 3072 + 2048 + h * 128 + sl * 32 + 16 * ct + fr] = f2bf(accY[ct][rg]);
                    }
            }
            accS[0] *= gl; accS[1] *= gl;
#pragma unroll
            for (int ks = 0; ks < 2; ++ks) {
#pragma unroll
                for (int ct = 0; ct < 2; ++ct) accS[ct] = __builtin_amdgcn_mfma_f32_16x16x32_bf16(R.ak[ks], bfv[ks][ct], accS[ct], 0, 0, 0);
            }
#pragma unroll
            for (int ct = 0; ct < 2; ++ct) { u32x2 o; o[0] = cvt_pk_bf16(accS[ct][0], accS[ct][1]); o[1] = cvt_pk_bf16(accS[ct][2], accS[ct][3]); *(LAS u32x2*)(STL + img128_byte(16 * ct + fr, 16 * wid + 4 * fq)) = o; }
            issue_rest(cs + 2, R);
        };
        BRegs R0, R1;
        issue_y(0, R0); issue_rest(0, R0); issue_y(1, R1); issue_rest(1, R1);
        for (int cs = 0; cs < nch; cs += 2) {
            body(cs, R0);
            if (cs + 1 < nch) body(cs + 1, R1);
        }
        __syncthreads();
        if (seg == 0 && !dry) { *(f32x4*)(SSAVE + ((size_t)wk * 512 + tid) * 8) = accS[0]; *(f32x4*)(SSAVE + ((size_t)wk * 512 + tid) * 8 + 4) = accS[1]; }
    }
}

__device__ __forceinline__ void phase_mix(const Params& p, int l, const bool dry = false) {
    int tid = threadIdx.x; asm volatile("" : "+v"(tid));
    const int wid = tid >> 6, lane = tid & 63;
    const int gw = blockIdx.x * 8 + wid, nw = gridDim.x * 8;
    const bf16_t* QKV = (const bf16_t*)(p.ws + OFF_QKV); bf16_t* ZG = (bf16_t*)(p.ws + OFF_ZG); const bf16_t* U = (const bf16_t*)(p.ws + OFF_U);
    const float* og = p.out_g + (size_t)l * 128 + (lane & 7) * 16;
    const float* cw = p.sc_conv_w + (size_t)l * 3 * 1024 + lane * 16;
    float ogr[16];
#pragma unroll
    for (int e = 0; e < 16; ++e) ogr[e] = og[e];
    for (int rb = gw * 4; rb < MROWS; rb += nw * 4) {
        u32x4 ov[4][2], zv[4][2];
#pragma unroll
        for (int k = 0; k < 4; ++k) {
            const size_t r = (size_t)(rb + k);
            ov[k][0] = *(const u32x4*)(QKV + r * 3072 + 2048 + lane * 16); ov[k][1] = *(const u32x4*)(QKV + r * 3072 + 2048 + lane * 16 + 8);
            zv[k][0] = *(const u32x4*)(ZG + r * 2048 + lane * 16); zv[k][1] = *(const u32x4*)(ZG + r * 2048 + lane * 16 + 8);
        }
#pragma unroll
        for (int k = 0; k < 4; ++k) {
            const size_t r = (size_t)(rb + k);
            float o[16], z[16];
#pragma unroll
            for (int q = 0; q < 4; ++q) { o[2 * q] = bf_lo(ov[k][0][q]); o[2 * q + 1] = bf_hi(ov[k][0][q]); o[8 + 2 * q] = bf_lo(ov[k][1][q]); o[8 + 2 * q + 1] = bf_hi(ov[k][1][q]);
                z[2 * q] = bf_lo(zv[k][0][q]); z[2 * q + 1] = bf_hi(zv[k][0][q]); z[8 + 2 * q] = bf_lo(zv[k][1][q]); z[8 + 2 * q + 1] = bf_hi(zv[k][1][q]); }
            float ss = 0.f;
#pragma unroll
            for (int e = 0; e < 16; ++e) ss += o[e] * o[e];
            ss += __shfl_xor(ss, 1); ss += __shfl_xor(ss, 2); ss += __shfl_xor(ss, 4);
            const float rstd = rsqrtf(ss * (1.f / 128.f) + EPS);
            float y[16];
#pragma unroll
            for (int e = 0; e < 16; ++e) y[e] = o[e] * rstd * ogr[e] * silu_f(z[e]);
            u32x4 w0, w1;
#pragma unroll
            for (int q = 0; q < 4; ++q) { w0[q] = cvt_pk_bf16(y[2 * q], y[2 * q + 1]); w1[q] = cvt_pk_bf16(y[8 + 2 * q], y[8 + 2 * q + 1]); }
            if (!dry) { *(u32x4*)(ZG + r * 2048 + lane * 16) = w0; *(u32x4*)(ZG + r * 2048 + lane * 16 + 8) = w1; }
        }
    }
    const bf16_t* UH = U; const bf16_t* GH = U + (size_t)2 * 1024 * 1024;
    for (int it = gw; it < 2 * (MPAD / 64); it += nw) {
        const int kb = it >> 1, which = it & 1, r = 64 * kb + which;
        if (kb >= 1 && r < MROWS) {
            const int b = r / LTOK, t = r - b * LTOK;
            const bf16_t* um2p = UH + ((size_t)(kb - 1) * 2 + (which ? 1 : 0)) * 1024 + lane * 16;
            const bf16_t* um1p = UH + ((size_t)(kb - 1) * 2 + 1) * 1024 + lane * 16;
            const bf16_t* gp = GH + ((size_t)kb * 2 + which) * 1024 + lane * 16;
            bf16_t* yp = ZG + (size_t)r * 2048 + 1024 + lane * 16;
            const float m2 = (t >= 2) ? 1.f : 0.f, m1 = (which == 0 && t >= 1) ? 1.f : 0.f;
#pragma unroll
            for (int hh = 0; hh < 2; ++hh) {
                const u32x4 a2 = *(const u32x4*)(um2p + 8 * hh), a1 = *(const u32x4*)(um1p + 8 * hh), gg = *(const u32x4*)(gp + 8 * hh), yy = *(const u32x4*)(yp + 8 * hh);
                u32x4 o;
#pragma unroll
                for (int q = 0; q < 4; ++q) {
                    const int e = 8 * hh + 2 * q;
                    const float c0 = bf_lo(gg[q]) * (m2 * cw[e] * bf_lo(a2[q]) + m1 * cw[1024 + e] * bf_lo(a1[q]));
                    const float c1 = bf_hi(gg[q]) * (m2 * cw[e + 1] * bf_hi(a2[q]) + m1 * cw[1024 + e + 1] * bf_hi(a1[q]));
                    o[q] = cvt_pk_bf16(bf_lo(yy[q]) + c0, bf_hi(yy[q]) + c1);
                }
                if (!dry) *(u32x4*)(yp + 8 * hh) = o;
            }
        }
    }
}

__device__ __forceinline__ void phase_final(const Params& p) {
    int tid = threadIdx.x; asm volatile("" : "+v"(tid));
    const int wid = tid >> 6, lane = tid & 63;
    const int gw = blockIdx.x * 8 + wid, nw = gridDim.x * 8;
    for (int r = gw; r < 8 * 4096; r += nw) {
        float* s = p.out + (size_t)r * 1024;
        f32x4 v[4]; float ss = 0.f;
#pragma unroll
        for (int q = 0; q < 4; ++q) { v[q] = *(const f32x4*)(s + lane * 4 + 256 * q); ss += v[q][0] * v[q][0] + v[q][1] * v[q][1] + v[q][2] * v[q][2] + v[q][3] * v[q][3]; }
#pragma unroll
        for (int o = 32; o >= 1; o >>= 1) ss += __shfl_xor(ss, o);
        const float rstd = rsqrtf(ss * (1.f / 1024.f) + EPS);
#pragma unroll
        for (int q = 0; q < 4; ++q) { const f32x4 gq = *(const f32x4*)(p.final_g + lane * 4 + 256 * q); *(f32x4*)(s + lane * 4 + 256 * q) = v[q] * rstd * gq; }
    }
}

#define XB_TMO      128
#define XB_XCNT(j)  (256  + 64 * (j))
#define XB_XSUB(j)  (1280 + 64 * (j))
#define XB_XGEN(j)  (2304 + 64 * (j))
#define XB_TOP      3328
#define XB_TOPGEN   3392
#define XCD_BAR_WORDS 3456
#define XB_SPIN_CAP (1u << 24)
__device__ __forceinline__ unsigned xb_ld(unsigned* p)              { return __hip_atomic_load(p, __ATOMIC_RELAXED, __HIP_MEMORY_SCOPE_AGENT); }
__device__ __forceinline__ unsigned xb_add(unsigned* p, unsigned v) { return __hip_atomic_fetch_add(p, v, __ATOMIC_RELAXED, __HIP_MEMORY_SCOPE_AGENT); }
__device__ __forceinline__ unsigned xb_xcc_id() { return (unsigned)__builtin_amdgcn_s_getreg((3 << 11) | 20) & 0xFu; }
#define XB_SPIN(cond, bar) do { unsigned _sp = 0; while (cond) { __builtin_amdgcn_s_sleep(1); \
    if ((++_sp & 255u) == 0u) { if (xb_ld(&(bar)[XB_TMO])) break; if (_sp > XB_SPIN_CAP) { atomicAdd(&(bar)[XB_TMO], 1u); break; } } } } while (0)
struct XcdBarrier { unsigned* bar; unsigned x; volatile LAS unsigned* st; };
__device__ __forceinline__ XcdBarrier xcd_barrier_post(unsigned* bar, volatile LAS unsigned* st) {
    XcdBarrier b; b.bar = bar; b.x = xb_xcc_id(); b.st = st;
    if (threadIdx.x == 0) (void)xb_add(&bar[XB_XCNT(b.x)], 1u);
    return b;
}
__device__ __forceinline__ void xcd_barrier_complete(unsigned* bar, unsigned x, unsigned& nloc, unsigned& nx) {
    const unsigned G = gridDim.x * gridDim.y * gridDim.z;
    unsigned sum, cnt, mine, sp = 0u;
    for (;;) {
        sum = 0u; cnt = 0u; mine = 0u;
#pragma unroll
        for (unsigned j = 0; j < 16; ++j) { const unsigned c = xb_ld(&bar[XB_XCNT(j)]); sum += c; cnt += (c > 0u) ? 1u : 0u; mine = (j == x) ? c : mine; }
        if (sum == G) break;
        __builtin_amdgcn_s_sleep(1);
        if ((++sp & 255u) == 0u) { if (xb_ld(&bar[XB_TMO])) break; if (sp > XB_SPIN_CAP) { atomicAdd(&bar[XB_TMO], 1u); break; } }
    }
    nloc = mine > 0u ? mine : 1u; nx = cnt > 0u ? cnt : 1u;
}
__device__ __forceinline__ void xcd_barrier(const XcdBarrier& b) {
    asm volatile("s_waitcnt vmcnt(0)" ::: "memory");
    __syncthreads();
    if (threadIdx.x == 0) {
        unsigned* bar = b.bar;
        __builtin_amdgcn_s_waitcnt(0);
        unsigned nloc = b.st[0], nx = b.st[1];
        if (nloc == 0u) { xcd_barrier_complete(bar, b.x, nloc, nx); b.st[0] = nloc; b.st[1] = nx; }
        const unsigned old = xb_add(&bar[XB_XSUB(b.x)], 1u);
        const unsigned gen = old / nloc;
        if (old + 1u == (gen + 1u) * nloc) {
            __builtin_amdgcn_fence(__ATOMIC_RELEASE, "agent");
            asm volatile("s_waitcnt vmcnt(0)" ::: "memory");
            const unsigned og = xb_add(&bar[XB_TOP], 1u);
            const unsigned tg = og / nx;
            if (og + 1u == (tg + 1u) * nx) xb_add(&bar[XB_TOPGEN], 1u);
            else XB_SPIN(xb_ld(&bar[XB_TOPGEN]) == tg, bar);
            __builtin_amdgcn_fence(__ATOMIC_ACQUIRE, "agent");
            xb_add(&bar[XB_XGEN(b.x)], 1u);
            asm volatile("s_waitcnt vmcnt(0)" ::: "memory");
        } else {
            XB_SPIN(xb_ld(&bar[XB_XGEN(b.x)]) == gen, bar);
            __builtin_amdgcn_fence(__ATOMIC_ACQUIRE, "agent");
            asm volatile("s_waitcnt vmcnt(0)" ::: "memory");
        }
    }
    __syncthreads();
}

constexpr int N_PHASES = 33;
#ifndef PHM
#define PHM 63
#endif

__global__ void __launch_bounds__(512, 2) mega(Params p) {
    extern __shared__ __attribute__((aligned(16))) unsigned char shm[];
    LAS unsigned char* lds = (LAS unsigned char*)shm;
#ifdef PROBE_SEL
    unsigned long long tprev = __builtin_amdgcn_s_memrealtime(); float tacc[8] = {0.f, 0.f, 0.f, 0.f, 0.f, 0.f, 0.f, 0.f};
#endif
    XcdBarrier xb; xb.bar = (unsigned*)(p.ws + OFF_BAR); xb.x = 0; xb.st = (volatile LAS unsigned*)(lds + LDS_BYTES - 16);
    if (p.ph_hi - p.ph_lo > 1) {
        if (threadIdx.x == 0) { xb.st[0] = 0u; xb.st[1] = 0u; }
        __syncthreads();
        xb = xcd_barrier_post((unsigned*)(p.ws + OFF_BAR), (volatile LAS unsigned*)(lds + LDS_BYTES - 16));
        if (threadIdx.x == 0) { xb.st[2] = xb.x; xb.st[3] = xb_add(xb.bar + 8 * (xb.x & 7u), 1u); }
    }
    int cwork = blockIdx.x;
    for (int ph = p.ph_lo; ph < p.ph_hi; ++ph) {
        if (ph == p.ph_lo + 1) {
            cg::this_grid().sync();
            if (gridDim.x == 256) {
                if (threadIdx.x == 0) {
                    bool ok = xb.st[2] < 8u;
#pragma unroll
                    for (int j = 0; j < 8; ++j) ok = ok && (xb_ld(xb.bar + 8 * j) == 32u);
                    xb.st[2] = ok ? (xb.st[2] + 8u * xb.st[3]) : (unsigned)blockIdx.x;
                }
                __syncthreads();
                cwork = __builtin_amdgcn_readfirstlane((int)xb.st[2]);
            }
        }
        else if (ph > p.ph_lo) xcd_barrier(xb);
#ifdef PROBE_SEL
        if (ph > p.ph_lo) { const unsigned long long tn = __builtin_amdgcn_s_memrealtime(); const float d = (float)(tn - tprev) * 0.01f; tprev = tn; const int ps = (ph - 1) & 7;
#pragma unroll
            for (int q = 0; q < 8; ++q) if (q == ps) tacc[q] += d; }
#endif
        if (ph == 32) { phase_final(p);
#ifdef PROBE_SEL
            __syncthreads();
            if (blockIdx.x == 0 && threadIdx.x == 0) {
                float a, b;
                if (PROBE_SEL == 0) { a = tacc[2] + tacc[4]; b = tacc[3] + tacc[5]; }
                else if (PROBE_SEL == 1) { a = tacc[1]; b = tacc[7]; }
                else { a = tacc[0]; b = tacc[6]; }
                p.out[0] = a; p.out[1024] = b;
            }
#endif
            continue; }
        const int l = ph >> 3, s = ph & 7;
#ifdef DUPSEL
        if ((DUPSEL >> s) & 1) {
            if (s == 0) phase_prep(p, l);
            else if (s == 2 || s == 4) stage_a(p, l, s == 4 ? 1 : 0, lds, true);
            else if (s == 3 || s == 5) stage_b(p, s == 5 ? 1 : 0, lds, true);
            else if (s == 6) phase_mix(p, l, true);
            cg::this_grid().sync();
        }
#endif
        if (s == 0) { if (PHM & 1) phase_prep(p, l); }
        else if (s == 1) { if (PHM & 2) {
            pg8::Gemm g; g.A = (const bf16_t*)(p.ws + OFF_X); g.Bt = (const bf16_t*)(p.ws + OFF_WIN); g.M = MPAD; g.N = N1; g.K = 1024;
            pg8::StaticOrder<false> S; S.init(MPAD, N1, 1024, gridDim.x, cwork);
            Epi1 E; E.QKV = (bf16_t*)(p.ws + OFF_QKV); E.ZG = (bf16_t*)(p.ws + OFF_ZG); E.U = (bf16_t*)(p.ws + OFF_U); E.AB = (float*)(p.ws + OFF_AB); E.HALO = (bf16_t*)(p.ws + OFF_HALO);
            E.A_log = p.A_log + l * 8; E.dt_bias = p.dt_bias + l * 8; E.scw = p.sc_conv_w + (size_t)l * 3 * 1024;
            pg8::gemm_phase(lds, g, S, E); }
        }
        else if (s == 2 || s == 4) { if (PHM & 4) stage_a(p, l, s == 4 ? 1 : 0, lds, false, cwork); }
        else if (s == 3 || s == 5) { if (PHM & 8) stage_b(p, s == 5 ? 1 : 0, lds, false, cwork); }
        else if (s == 6) { if (PHM & 16) phase_mix(p, l); }
        else if (PHM & 32) {
            pg8::Gemm g; g.A = (const bf16_t*)(p.ws + OFF_ZG); g.Bt = (const bf16_t*)(p.ws + OFF_WOUT); g.M = MPAD; g.N = 1024; g.K = 2048;
            pg8::StaticOrder<true> S; S.init(MPAD - 256, 1024, 2048, gridDim.x, cwork);
            Epi2 E; E.src_real = (l == 0) ? p.x : (const float*)p.out; E.src_meta = (l == 0) ? p.meta : (const float*)(p.ws + OFF_HMETA); E.meta_bstride = (l == 0) ? 0 : 16;
            E.dst_real = p.out; E.dst_meta = (float*)(p.ws + OFF_HMETA);
            pg8::gemm_phase(lds, g, S, E);
        }
    }
}

extern "C" void kernel_launch(void* const* d_in, const int* in_sizes, int n_in, void* d_out, int out_size, void* d_ws, size_t ws_size, hipStream_t stream) {
    static int grid = 0;
    if (grid == 0) {
        if (n_in != 11 || ws_size < WS_END2) { fprintf(stderr, "kernel_launch: bad inputs / workspace (%zu < %zu)\n", ws_size, (size_t)WS_END2); grid = -1; return; }
        int dev = 0, cus = 0, per_cu = 0;
        hipGetDevice(&dev);
        hipDeviceGetAttribute(&cus, hipDeviceAttributeMultiprocessorCount, dev);
        hipFuncSetAttribute((const void*)mega, hipFuncAttributeMaxDynamicSharedMemorySize, LDS_BYTES);
        hipOccupancyMaxActiveBlocksPerMultiprocessor(&per_cu, (const void*)mega, 512, LDS_BYTES);
        if (per_cu < 1) per_cu = 1;
        if (per_cu > 1) per_cu = 1;
        grid = cus * per_cu;
        (void)hipGetLastError();
    }
    if (grid < 0) return;
    Params p{};
    p.x = (const float*)d_in[0]; p.meta = (const float*)d_in[1]; p.norm_g = (const float*)d_in[2]; p.w_in = (const float*)d_in[3]; p.dn_conv_w = (const float*)d_in[4];
    p.A_log = (const float*)d_in[5]; p.dt_bias = (const float*)d_in[6]; p.out_g = (const float*)d_in[7]; p.sc_conv_w = (const float*)d_in[8]; p.w_out = (const float*)d_in[9]; p.final_g = (const float*)d_in[10];
    p.out = (float*)d_out; p.ws = (unsigned char*)d_ws;
#if N_LAUNCH_MODE == 1
    for (int ph = 0; ph < N_PHASES; ++ph) {
        p.ph_lo = ph; p.ph_hi = ph + 1;
        hipLaunchKernelGGL(mega, dim3(grid), dim3(512), LDS_BYTES, stream, p);
    }
#else
    p.ph_lo = 0; p.ph_hi = N_PHASES;
    (void)hipMemsetAsync((unsigned char*)d_ws + OFF_BAR, 0, XCD_BAR_WORDS * 4, stream);
    void* args[] = {&p};
    hipError_t e = hipLaunchCooperativeKernel((const void*)mega, dim3(grid), dim3(512), args, LDS_BYTES, stream);
    if (e != hipSuccess) fprintf(stderr, "cooperative launch failed: %s (grid %d)\n", hipGetErrorString(e), grid);
#endif
}
```

```cpp
#include <hip/hip_runtime.h>
#include <hip/hip_cooperative_groups.h>
#include <cstdio>
namespace cg = cooperative_groups;

#ifndef N_LAUNCH_MODE
#define N_LAUNCH_MODE 0
#endif

#define LAS __attribute__((address_space(3)))
typedef unsigned short bf16_t;
typedef short bf16x8 __attribute__((ext_vector_type(8)));
typedef float f32x4 __attribute__((ext_vector_type(4)));
typedef unsigned u32x4 __attribute__((ext_vector_type(4)));
typedef unsigned u32x2 __attribute__((ext_vector_type(2)));

constexpr int LTOK = 4112, MROWS = 32896, MPAD = 33024, NCH = 65, N1 = 8448, INCOLS = 8208;
constexpr int SEG0 = 33;
constexpr float EPS = 1e-6f;
constexpr int LDS_BYTES = 147456;

constexpr size_t SZ_QKV = (size_t)MROWS * 3072 * 2, SZ_ZG = (size_t)MPAD * 2048 * 2, SZ_U = (size_t)MROWS * 1024 * 2;
constexpr size_t SZ_WIN = (size_t)N1 * 1024 * 2, SZ_WOUT = (size_t)1024 * 2048 * 2, SZ_AB = (size_t)MROWS * 16 * 4;
constexpr size_t SZ_HMETA = (size_t)128 * 1024 * 4, SZ_GLAST = 16896, SZ_SSAVE = (size_t)256 * 512 * 8 * 4;
constexpr size_t SZ_HALO = (size_t)8 * 65 * 3 * 3072 * 2, SZ_X = (size_t)MPAD * 1024 * 2;
constexpr size_t OFF_QKV = 0, OFF_ZG = OFF_QKV + SZ_QKV, OFF_U = OFF_ZG + SZ_ZG, OFF_WIN = OFF_U + SZ_U, OFF_WOUT = OFF_WIN + SZ_WIN;
constexpr size_t OFF_AB = OFF_WOUT + SZ_WOUT, OFF_HMETA = OFF_AB + SZ_AB, OFF_GLAST = OFF_HMETA + SZ_HMETA, OFF_SSAVE = OFF_GLAST + SZ_GLAST;
constexpr size_t OFF_HALO = OFF_SSAVE + SZ_SSAVE, OFF_X = OFF_HALO + SZ_HALO, WS_END = OFF_X + SZ_X;
constexpr size_t OFF_BAR = WS_END, WS_END2 = WS_END + 16384;
constexpr size_t OFF_KDT = OFF_X, OFF_PIMG = OFF_X + (size_t)64 * SEG0 * 16384;
static_assert(OFF_PIMG + (size_t)64 * SEG0 * 8192 <= WS_END, "ext images must fit");

struct Params {
    const float *x, *meta, *norm_g, *w_in, *dn_conv_w, *A_log, *dt_bias, *out_g, *sc_conv_w, *w_out, *final_g;
    float* out; unsigned char* ws; int ph_lo, ph_hi;
};

typedef float f32x2 __attribute__((ext_vector_type(2)));
typedef __bf16 bf16x2_n __attribute__((ext_vector_type(2)));
__device__ __forceinline__ unsigned cvt_pk_bf16(float lo, float hi) { f32x2 v = {lo, hi}; bf16x2_n b = __builtin_convertvector(v, bf16x2_n); return __builtin_bit_cast(unsigned, b); }
__device__ __forceinline__ bf16_t f2bf(float f) { unsigned u = __float_as_uint(f); u += 0x7FFFu + ((u >> 16) & 1u); return (bf16_t)(u >> 16); }
__device__ __forceinline__ float bf_lo(unsigned w) { return __uint_as_float(w << 16); }
__device__ __forceinline__ float bf_hi(unsigned w) { return __uint_as_float(w & 0xffff0000u); }
__device__ __forceinline__ float bf2f(bf16_t v) { return __uint_as_float(((unsigned)v) << 16); }
__device__ __forceinline__ float silu_f(float v) { return v * __builtin_amdgcn_rcpf(1.f + __expf(-v)); }
__device__ __forceinline__ float dpp_shr1(float v) { float r; asm volatile("s_nop 1\n\tv_mov_b32_dpp %0, %1 row_shr:1 row_mask:0xf bank_mask:0xf bound_ctrl:1" : "=v"(r) : "v"(v)); return r; }
__device__ __forceinline__ float dpp_shr2(float v) { float r; asm volatile("s_nop 1\n\tv_mov_b32_dpp %0, %1 row_shr:2 row_mask:0xf bank_mask:0xf bound_ctrl:1" : "=v"(r) : "v"(v)); return r; }
__device__ __forceinline__ float dpp_ror1(float v) { float r; asm volatile("s_nop 1\n\tv_mov_b32_dpp %0, %1 row_ror:1 row_mask:0xf bank_mask:0xf bound_ctrl:1" : "=v"(r) : "v"(v)); return r; }
__device__ __forceinline__ float dpp_ror2(float v) { float r; asm volatile("s_nop 1\n\tv_mov_b32_dpp %0, %1 row_ror:2 row_mask:0xf bank_mask:0xf bound_ctrl:1" : "=v"(r) : "v"(v)); return r; }
__device__ __forceinline__ int img128_byte(int row, int elem) { return row * 256 + ((((elem >> 3) ^ (row & 15))) << 4) + (elem & 7) * 2; }
__device__ __forceinline__ int img64_byte(int row, int elem) { return row * 128 + ((((elem >> 3) ^ ((row >> 1) & 7))) << 4) + (elem & 7) * 2; }

namespace pg8 {
constexpr int BM = 256, BK = 64, HALF = 128, HTB = HALF * BK * 2, STAGE_BYTES = 8 * HTB, NXCD = 8, WGM = 8;
__device__ __forceinline__ int lds_byte(int r, int c) { const int st = (r >> 4) * 2 + (c >> 5), rr = r & 15, cc = c & 31, ob = rr * 64 + cc * 2; return st * 1024 + (ob ^ (((ob >> 9) & 1) << 5)); }
__device__ __forceinline__ void stage_rc(int b, int& R, int& C) { const int st = b / 1024, sb = b % 1024, swz = sb ^ (((sb >> 9) & 1) << 5); R = (st >> 1) * 16 + swz / 64; C = (st & 1) * 32 + (swz % 64) / 2; }
struct Unit { int pm, pn, k0, nt; };
struct Gemm { const bf16_t* A; const bf16_t* Bt; int M, N, K; };
template <bool TAIL> struct StaticOrder {
    int nM, nN, nwg, G, c, ntk;
    __device__ __forceinline__ void init(int M, int N, int K, int G_, int c_) { nM = M / BM; nN = N / BM; nwg = nM * nN; G = G_; c = c_; ntk = K / BK; }
    __device__ __forceinline__ bool next(int i, Unit& u) const {
        const long L = (long)i * G + c;
        if (L >= nwg + (TAIL ? 4 * nN : 0)) return false;
        int pm, pn, k0, nt;
        if (TAIL && L >= nwg) { const int idx = (int)(L - nwg); pm = nM; pn = idx % nN; nt = ntk / 4; k0 = (idx / nN) * (ntk / 4) * BK; }
        else {
            int wgid = (int)L; { const int q = nwg / NXCD, r = nwg % NXCD, xcd = wgid % NXCD, off = wgid / NXCD; wgid = (xcd < r ? xcd * (q + 1) : r * (q + 1) + (xcd - r) * q) + off; }
            const int nig = WGM * nN, gid = wgid / nig, fm = gid * WGM, gsz = (nM - fm) < WGM ? (nM - fm) : WGM;
            pm = fm + ((wgid % nig) % gsz); pn = (wgid % nig) / gsz; k0 = 0; nt = ntk;
        }
        u.pm = pm; u.pn = pn; u.k0 = k0; u.nt = nt; return true;
    }
};

template <class Epi, class Sched>
__device__ __forceinline__ void gemm_phase(LAS unsigned char* lds, const Gemm g, const Sched& S, const Epi& E) {
    int tid = threadIdx.x; asm volatile("" : "+v"(tid));
    const int wid = __builtin_amdgcn_readfirstlane(tid >> 6), lane = tid & 63, wr = wid >> 2, wc = wid & 3, fr = lane & 15, fq = lane >> 4;
    const int K = g.K;
    unsigned voffA[2], voffB[2];
#pragma unroll
    for (int i = 0; i < 2; ++i) { int R, C; stage_rc(tid * 16 + i * 8192, R, C); voffA[i] = (unsigned)(R * K + C) * 2u; voffB[i] = (unsigned)(R * K + C) * 2u; }
    const size_t kstep = (size_t)(BK * 2);
    const size_t hstep = (size_t)HALF * K * 2;
    const size_t tstep = 2 * hstep;
    const unsigned ldsw = (unsigned)wid * 1024u;
    const int aoff = lds_byte(wr * 64 + fr, fq * 8), boff = lds_byte(wc * 32 + fr, fq * 8);
#define PG8_SA(b, h) (((b) * 2 + (h)) * HTB)
#define PG8_SB(b, h) ((4 + (b) * 2 + (h)) * HTB)
#define PG8_STAGE(bufoff, gbase, voff) do { _Pragma("unroll") for (int _i = 0; _i < 2; ++_i) \
        __builtin_amdgcn_global_load_lds((const unsigned*)((const char*)(gbase) + (voff)[_i]), (LAS unsigned*)(lds + (bufoff) + ldsw + _i * 8192), 16, 0, 0); } while (0)
#define PG8_LDA(dst, b, h) do { _Pragma("unroll") for (int m = 0; m < 4; ++m) _Pragma("unroll") for (int k = 0; k < 2; ++k) dst[m][k] = *(const LAS bf16x8*)(lds + PG8_SA(b, h) + aoff + m * 2048 + k * 1024); } while (0)
#define PG8_LDB(dst, b, h) do { _Pragma("unroll") for (int n = 0; n < 2; ++n) _Pragma("unroll") for (int k = 0; k < 2; ++k) dst[n][k] = *(const LAS bf16x8*)(lds + PG8_SB(b, h) + boff + n * 2048 + k * 1024); } while (0)
#define PG8_MMA(ai, bj, At, Bt) do { __builtin_amdgcn_s_setprio(1); _Pragma("unroll") for (int m = 0; m < 4; ++m) _Pragma("unroll") for (int n = 0; n < 2; ++n) _Pragma("unroll") for (int k = 0; k < 2; ++k) \
        acc[ai][bj][m][n] = __builtin_amdgcn_mfma_f32_16x16x32_bf16(Bt[n][k], At[m][k], acc[ai][bj][m][n], 0, 0, 0); __builtin_amdgcn_s_setprio(0); } while (0)
#define PG8_WAIT_V(n) asm volatile("s_waitcnt vmcnt(" #n ")" ::: "memory")
#define PG8_WAIT_L(n) asm volatile("s_waitcnt lgkmcnt(" #n ")" ::: "memory")
#define PG8_BAR __builtin_amdgcn_s_barrier()
#define PG8_SCHED __builtin_amdgcn_sched_barrier(0)
    Unit cur, nxt; int ui = 0;
    if (!S.next(0, cur)) return;
    f32x4 acc[2][2][4][2];
#pragma unroll
    for (int a = 0; a < 2; ++a)
#pragma unroll
        for (int b = 0; b < 2; ++b)
#pragma unroll
            for (int m = 0; m < 4; ++m)
#pragma unroll
                for (int n = 0; n < 2; ++n) acc[a][b][m][n] = (f32x4){0.f, 0.f, 0.f, 0.f};
    bf16x8 At[4][2], B0[2][2], B1[2][2];
    const char* cA = (const char*)g.A + (size_t)cur.pm * tstep + (size_t)cur.k0 * 2; const char* cB = (const char*)g.Bt + (size_t)cur.pn * tstep + (size_t)cur.k0 * 2;
    PG8_STAGE(PG8_SB(0, 0), cB, voffB); PG8_STAGE(PG8_SA(0, 0), cA, voffA); PG8_STAGE(PG8_SB(0, 1), cB + hstep, voffB); PG8_STAGE(PG8_SA(0, 1), cA + hstep, voffA);
    if (wr == 1) PG8_BAR;
    PG8_WAIT_V(4); PG8_BAR;
    PG8_STAGE(PG8_SB(1, 0), cB + kstep, voffB); PG8_STAGE(PG8_SA(1, 0), cA + kstep, voffA); PG8_STAGE(PG8_SB(1, 1), cB + hstep + kstep, voffB);
    PG8_WAIT_V(6); PG8_BAR;
    for (;;) {
        const bool has_next = S.next(ui + 1, nxt);
        const char* nA = has_next ? (const char*)g.A + (size_t)nxt.pm * tstep + (size_t)nxt.k0 * 2 : cA; const char* nB = has_next ? (const char*)g.Bt + (size_t)nxt.pn * tstep + (size_t)nxt.k0 * 2 : cB;
        const int nt = cur.nt;
        for (int t = 0; t < nt; t += 2) {
            const bool last = (t == nt - 2);
            const char* a1 = cA + (size_t)(t + 1) * kstep;
            const char* a2 = last ? nA : cA + (size_t)(t + 2) * kstep; const char* b2 = last ? nB : cB + (size_t)(t + 2) * kstep;
            const char* a3 = a2 + kstep; const char* b3 = b2 + kstep;
            PG8_LDB(B0, 0, 0); PG8_SCHED; PG8_LDA(At, 0, 0); PG8_STAGE(PG8_SA(1, 1), a1 + hstep, voffA);
            PG8_WAIT_L(8); PG8_BAR; PG8_WAIT_L(0); PG8_MMA(0, 0, At, B0); PG8_BAR; PG8_SCHED;
            PG8_LDB(B1, 0, 1); PG8_STAGE(PG8_SB(0, 0), b2, voffB);
            PG8_BAR; PG8_WAIT_L(0); PG8_MMA(0, 1, At, B1); PG8_BAR;
            PG8_LDA(At, 0, 1); PG8_STAGE(PG8_SA(0, 0), a2, voffA);
            PG8_BAR; PG8_WAIT_L(0); PG8_MMA(1, 0, At, B0); PG8_BAR; PG8_SCHED;
            PG8_STAGE(PG8_SB(0, 1), b2 + hstep, voffB);
            PG8_WAIT_V(6); PG8_BAR; PG8_MMA(1, 1, At, B1); PG8_BAR;
            PG8_LDB(B0, 1, 0); PG8_SCHED; PG8_LDA(At, 1, 0); PG8_STAGE(PG8_SA(0, 1), a2 + hstep, voffA);
            PG8_WAIT_L(8); PG8_BAR; PG8_WAIT_L(0); PG8_MMA(0, 0, At, B0); PG8_BAR; PG8_SCHED;
            PG8_LDB(B1, 1, 1); PG8_STAGE(PG8_SB(1, 0), b3, voffB);
            PG8_BAR; PG8_WAIT_L(0); PG8_MMA(0, 1, At, B1); PG8_BAR;
            PG8_LDA(At, 1, 1); PG8_STAGE(PG8_SA(1, 0), a3, voffA);
            PG8_BAR; PG8_WAIT_L(0); PG8_MMA(1, 0, At, B0); PG8_BAR; PG8_SCHED;
            PG8_STAGE(PG8_SB(1, 1), b3 + hstep, voffB);
            PG8_WAIT_V(6); PG8_BAR; PG8_MMA(1, 1, At, B1); PG8_BAR;
        }
        E(acc, cur, wr, wc, fr, fq);
        if (!has_next) break;
#pragma unroll
        for (int a = 0; a < 2; ++a)
#pragma unroll
            for (int b = 0; b < 2; ++b)
#pragma unroll
                for (int m = 0; m < 4; ++m)
#pragma unroll
                    for (int n = 0; n < 2; ++n) acc[a][b][m][n] = (f32x4){0.f, 0.f, 0.f, 0.f};
        cur = nxt; cA = nA; cB = nB; ++ui;
    }
    PG8_WAIT_V(0);
    if (wr == 0) PG8_BAR;
    PG8_BAR;
#undef PG8_SA
#undef PG8_SB
#undef PG8_STAGE
#undef PG8_LDA
#undef PG8_LDB
#undef PG8_MMA
#undef PG8_WAIT_V
#undef PG8_WAIT_L
#undef PG8_BAR
#undef PG8_SCHED
}
}

struct Epi1 {
    bf16_t* QKV; bf16_t* ZG; bf16_t* U; float* AB; bf16_t* HALO; const float* A_log; const float* dt_bias; const float* scw;
    __device__ __forceinline__ void operator()(const f32x4 (&acc)[2][2][4][2], const pg8::Unit& u, int wr, int wc, int fr, int fq) const {
        const int row0 = u.pm * 256 + wr * 64 + fr;
        if (u.pn < 12) {
#pragma unroll
            for (int ai = 0; ai < 2; ++ai)
#pragma unroll
                for (int m = 0; m < 4; ++m) {
                    const int r = row0 + ai * 128 + m * 16;
                    if (r < MROWS) {
                        const int b = r / LTOK, t = r - b * LTOK, tm = t & 63, cn = (t >> 6) + 1;
                        const bool halo = (tm >= 13) && (tm <= 15) && (cn <= 64);
                        bf16_t* rp = QKV + (size_t)r * 3072 + u.pn * 256 + wc * 32 + fq * 8;
                        bf16_t* hp = HALO + ((size_t)((b * 65 + cn) * 3 + (tm - 13))) * 3072 + u.pn * 256 + wc * 32 + fq * 8;
#pragma unroll
                        for (int bj = 0; bj < 2; ++bj) {
                            const f32x4 v0 = acc[ai][bj][m][0], v1 = acc[ai][bj][m][1];
                            u32x4 pk; pk[0] = cvt_pk_bf16(v0[0], v0[1]); pk[1] = cvt_pk_bf16(v0[2], v0[3]); pk[2] = cvt_pk_bf16(v1[0], v1[1]); pk[3] = cvt_pk_bf16(v1[2], v1[3]);
                            __builtin_nontemporal_store(pk, (u32x4*)(rp + bj * 128));
                            if (halo) *(u32x4*)(hp + bj * 128) = pk;
                        }
                    }
                }
        } else if (u.pn < 16) {
#pragma unroll
            for (int ai = 0; ai < 2; ++ai)
#pragma unroll
                for (int m = 0; m < 4; ++m) {
                    const int r = row0 + ai * 128 + m * 16;
                    if (r < MROWS) {
                        bf16_t* rp = ZG + (size_t)r * 2048 + (u.pn - 12) * 256 + wc * 32 + fq * 8;
#pragma unroll
                        for (int bj = 0; bj < 2; ++bj) {
                            const f32x4 v0 = acc[ai][bj][m][0], v1 = acc[ai][bj][m][1];
                            u32x4 pk; pk[0] = cvt_pk_bf16(v0[0], v0[1]); pk[1] = cvt_pk_bf16(v0[2], v0[3]); pk[2] = cvt_pk_bf16(v1[0], v1[1]); pk[3] = cvt_pk_bf16(v1[2], v1[3]);
                            __builtin_nontemporal_store(pk, (u32x4*)(rp + bj * 128));
                        }
                    }
                }
        } else if (u.pn < 32) {
            const int ch = (u.pn - 16) * 64 + wc * 16 + fq * 4;
            const f32x4 cw0 = *(const f32x4*)(scw + ch), cw1 = *(const f32x4*)(scw + 1024 + ch), cw2 = *(const f32x4*)(scw + 2048 + ch);
            bf16_t* UH = U; bf16_t* GH = U + (size_t)2 * 1024 * 1024;
#pragma unroll
            for (int ai = 0; ai < 2; ++ai) {
                f32x4 uprev = (f32x4){0.f, 0.f, 0.f, 0.f};
#pragma unroll
                for (int m = 0; m < 4; ++m) {
                    const int r = row0 + ai * 128 + m * 16;
                    const f32x4 vb = acc[ai][0][m][0], vc = acc[ai][0][m][1], vh = acc[ai][1][m][0], vz = acc[ai][1][m][1];
                    f32x4 uu, gg, yy;
#pragma unroll
                    for (int e = 0; e < 4; ++e) { uu[e] = vc[e] * vh[e]; gg[e] = vb[e] * silu_f(vz[e]); }
                    const int b = r / LTOK, t = r - b * LTOK;
#pragma unroll
                    for (int e = 0; e < 4; ++e) {
                        const float s1 = dpp_shr1(uu[e]), s2 = dpp_shr2(uu[e]), r1 = dpp_ror1(uprev[e]), r2 = dpp_ror2(uprev[e]);
                        float p1 = fr >= 1 ? s1 : r1, p2 = fr >= 2 ? s2 : r2;
                        if (t < 1) p1 = 0.f;
                        if (t < 2) p2 = 0.f;
                        yy[e] = gg[e] * (cw0[e] * p2 + cw1[e] * p1 + cw2[e] * uu[e]);
                    }
                    if (r < MROWS) {
                        u32x2 py; py[0] = cvt_pk_bf16(yy[0], yy[1]); py[1] = cvt_pk_bf16(yy[2], yy[3]);
                        __builtin_nontemporal_store(py, (u32x2*)(ZG + (size_t)r * 2048 + 1024 + ch));
                        if (m == 3 && fr >= 14) { u32x2 pu; pu[0] = cvt_pk_bf16(uu[0], uu[1]); pu[1] = cvt_pk_bf16(uu[2], uu[3]); *(u32x2*)(UH + ((size_t)(r >> 6) * 2 + (fr - 14)) * 1024 + ch) = pu; }
                        if (m == 0 && fr <= 1) { u32x2 pg; pg[0] = cvt_pk_bf16(gg[0], gg[1]); pg[1] = cvt_pk_bf16(gg[2], gg[3]); *(u32x2*)(GH + ((size_t)(r >> 6) * 2 + fr) * 1024 + ch) = pg; }
                    }
                    uprev = uu;
                }
            }
        } else {
            if (wc == 0) {
#pragma unroll
                for (int ai = 0; ai < 2; ++ai)
#pragma unroll
                    for (int m = 0; m < 4; ++m) {
                        const int r = row0 + ai * 128 + m * 16;
                        if (r < MROWS) {
                            const f32x4 v = acc[ai][0][m][0];
                            f32x4 o;
#pragma unroll
                            for (int e = 0; e < 4; ++e) {
                                if (fq < 2) { const int hd = 4 * fq + e; const float xx = v[e] + dt_bias[hd]; const float sp = xx > 20.f ? xx : log1pf(__expf(xx)); o[e] = -__expf(A_log[hd]) * sp; }
                                else o[e] = 1.f / (1.f + __expf(-v[e]));
                            }
                            *(f32x4*)(AB + (size_t)r * 16 + 4 * fq) = o;
                        }
                    }
            }
        }
    }
};

struct Epi2 {
    const float* src_real; const float* src_meta; int meta_bstride; float* dst_real; float* dst_meta;
    __device__ __forceinline__ void operator()(const f32x4 (&acc)[2][2][4][2], const pg8::Unit& u, int wr, int wc, int fr, int fq) const {
        const int row0 = u.pm * 256 + wr * 64 + fr, col0 = u.pn * 256 + wc * 32 + 4 * fq;
        if (u.k0 != 0 || u.nt != 32) {
#pragma unroll
            for (int ai = 0; ai < 2; ++ai)
#pragma unroll
                for (int m = 0; m < 4; ++m) {
                    const int r = row0 + ai * 128 + m * 16;
                    if (r < MROWS) {
                        const int b = r / LTOK, t = r - b * LTOK;
                        float* d = (t < 16) ? dst_meta + (size_t)(b * 16 + t) * 1024 : dst_real + ((size_t)b * 4096 + (t - 16)) * 1024;
#pragma unroll
                        for (int bj = 0; bj < 2; ++bj)
#pragma unroll
                            for (int n = 0; n < 2; ++n)
#pragma unroll
                                for (int e = 0; e < 4; ++e) (void)__builtin_amdgcn_global_atomic_fadd_f32((__attribute__((address_space(1))) float*)(d + col0 + bj * 128 + n * 16 + e), acc[ai][bj][m][n][e]);
                    }
                }
            return;
        }
#pragma unroll
        for (int ai = 0; ai < 2; ++ai) {
            f32x4 res[4][2][2]; float* dp[4];
#pragma unroll
            for (int m = 0; m < 4; ++m) {
                int r = row0 + ai * 128 + m * 16; if (r >= MROWS) r = MROWS - 1;
                const int b = r / LTOK, t = r - b * LTOK;
                const float* s;
                if (t < 16) { s = src_meta + (size_t)(b * meta_bstride + t) * 1024; dp[m] = dst_meta + (size_t)(b * 16 + t) * 1024; }
                else { s = src_real + ((size_t)b * 4096 + (t - 16)) * 1024; dp[m] = dst_real + ((size_t)b * 4096 + (t - 16)) * 1024; }
#pragma unroll
                for (int bj = 0; bj < 2; ++bj)
#pragma unroll
                    for (int n = 0; n < 2; ++n) res[m][bj][n] = *(const f32x4*)(s + col0 + bj * 128 + n * 16);
            }
            __builtin_amdgcn_sched_barrier(0);
#pragma unroll
            for (int m = 0; m < 4; ++m) {
                const int r = row0 + ai * 128 + m * 16;
                if (r < MROWS) {
#pragma unroll
                    for (int bj = 0; bj < 2; ++bj)
#pragma unroll
                        for (int n = 0; n < 2; ++n) *(f32x4*)(dp[m] + col0 + bj * 128 + n * 16) = res[m][bj][n] + acc[ai][bj][m][n];
                }
            }
            __builtin_amdgcn_sched_barrier(0);
        }
    }
};

__device__ __forceinline__ int slot_to_col(int s) {
    if (s < 4096) { const int n = (s >> 4) & 1, fq = (s >> 2) & 3, e = s & 3; return (s & ~31) + 8 * fq + 4 * n + e; }
    if (s < 8192) { const int tl = (s - 4096) >> 8, ci = s & 255, bj = ci >> 7, wc = (ci >> 5) & 3, n = (ci >> 4) & 1, fq = (ci >> 2) & 3, e = ci & 3;
        return 4112 + (bj * 2 + n) * 1024 + tl * 64 + wc * 16 + fq * 4 + e; }
    s -= 8192; return s < 16 ? 4096 + s : -1;
}

__device__ __forceinline__ void phase_prep(const Params& p, int l) {
    int tid = threadIdx.x; asm volatile("" : "+v"(tid));
    const int wid = tid >> 6, lane = tid & 63;
    const int gw = blockIdx.x * 8 + wid, nw = gridDim.x * 8;
    bf16_t* WINT = (bf16_t*)(p.ws + OFF_WIN); bf16_t* WOUTT = (bf16_t*)(p.ws + OFF_WOUT); bf16_t* HN = (bf16_t*)(p.ws + OFF_X);
    for (int wt = gw; wt < 2112 + 512; wt += nw) {
        float v[64];
        bf16_t* dst;
        if (wt < 2112) {
            const int sb = wt >> 4, kb = wt & 15, slot = sb * 64 + lane, oc = slot_to_col(slot);
            const float* src = p.w_in + (size_t)l * 1024 * INCOLS + (size_t)(kb * 64) * INCOLS + (oc < 0 ? 0 : oc);
#pragma unroll
            for (int kk = 0; kk < 64; ++kk) v[kk] = src[(size_t)kk * INCOLS];
            if (oc < 0) {
#pragma unroll
                for (int kk = 0; kk < 64; ++kk) v[kk] = 0.f;
            }
            dst = WINT + (size_t)slot * 1024 + kb * 64;
        } else {
            const int w2 = wt - 2112, nb = w2 >> 5, kb = w2 & 31, n = nb * 64 + lane;
            const float* src = p.w_out + (size_t)l * 2048 * 1024 + (size_t)(kb * 64) * 1024 + n;
#pragma unroll
            for (int kk = 0; kk < 64; ++kk) v[kk] = src[(size_t)kk * 1024];
            dst = WOUTT + (size_t)n * 2048 + kb * 64;
        }
#pragma unroll
        for (int q = 0; q < 8; ++q) {
            u32x4 o; o[0] = cvt_pk_bf16(v[8 * q], v[8 * q + 1]); o[1] = cvt_pk_bf16(v[8 * q + 2], v[8 * q + 3]); o[2] = cvt_pk_bf16(v[8 * q + 4], v[8 * q + 5]); o[3] = cvt_pk_bf16(v[8 * q + 6], v[8 * q + 7]);
            *(u32x4*)(dst + 8 * q) = o;
        }
    }
    if (l == 0) {
        const int gi = blockIdx.x * 512 + tid;
        if (gi < 32768) *(f32x4*)(p.out + (size_t)32640 * 1024 + (size_t)gi * 4) = *(const f32x4*)(p.x + (size_t)32640 * 1024 + (size_t)gi * 4);
    }
    const float* gain = p.norm_g + (size_t)l * 1024;
    const float* HM = (const float*)(p.ws + OFF_HMETA);
    f32x4 gq[4];
#pragma unroll
    for (int q = 0; q < 4; ++q) gq[q] = *(const f32x4*)(gain + lane * 4 + 256 * q);
    for (int rb = gw * 4; rb < MROWS; rb += nw * 4) {
        f32x4 v[4][4];
#pragma unroll
        for (int k = 0; k < 4; ++k) {
            const int r = rb + k, b = r / LTOK, t = r - b * LTOK;
            const float* s;
            if (t < 16) s = (l == 0) ? p.meta + (size_t)t * 1024 : HM + (size_t)(b * 16 + t) * 1024;
            else s = ((l == 0) ? p.x : (const float*)p.out) + ((size_t)b * 4096 + (t - 16)) * 1024;
#pragma unroll
            for (int q = 0; q < 4; ++q) v[k][q] = *(const f32x4*)(s + lane * 4 + 256 * q);
        }
#pragma unroll
        for (int k = 0; k < 4; ++k) {
            float ss = 0.f;
#pragma unroll
            for (int q = 0; q < 4; ++q) ss += v[k][q][0] * v[k][q][0] + v[k][q][1] * v[k][q][1] + v[k][q][2] * v[k][q][2] + v[k][q][3] * v[k][q][3];
#pragma unroll
            for (int o = 32; o >= 1; o >>= 1) ss += __shfl_xor(ss, o);
            const float rstd = rsqrtf(ss * (1.f / 1024.f) + EPS);
#pragma unroll
            for (int q = 0; q < 4; ++q) {
                u32x2 o; o[0] = cvt_pk_bf16(v[k][q][0] * rstd * gq[q][0], v[k][q][1] * rstd * gq[q][1]); o[1] = cvt_pk_bf16(v[k][q][2] * rstd * gq[q][2], v[k][q][3] * rstd * gq[q][3]);
                *(u32x2*)(HN + (size_t)(rb + k) * 1024 + lane * 4 + 256 * q) = o;
            }
        }
    }
}

__device__ __forceinline__ void stage_a(const Params& p, int l, int seg, LAS unsigned char* lds, const bool dry = false) {
    bf16_t* QKV = (bf16_t*)(p.ws + OFF_QKV); const bf16_t* HALO = (const bf16_t*)(p.ws + OFF_HALO);
    const float* AB = (const float*)(p.ws + OFF_AB); float* GLAST = (float*)(p.ws + OFF_GLAST);
    LAS float* AM = (LAS float*)(lds); LAS unsigned char* KB = lds + 81920; LAS unsigned char* QB = lds + 98304;
    LAS unsigned char* RT = lds + 16384; LAS unsigned char* OUTS = lds + 49152; LAS unsigned char* XI = lds + 81920;
    LAS bf16_t* KDS = (LAS bf16_t*)(lds + 114688); LAS unsigned char* PS = lds + 132096; LAS float* GS = (LAS float*)(lds + 140288); LAS float* BS = (LAS float*)(lds + 140544);
    const int nchunks = seg == 0 ? SEG0 : NCH - SEG0, c_lo = seg == 0 ? 0 : SEG0, ntasks = 64 * nchunks;
    LAS float* CW = (LAS float*)(lds + 140800);
    int h_loaded = -1;
    for (int task = blockIdx.x; task < ntasks; task += gridDim.x) {
        int tid = threadIdx.x; asm volatile("" : "+v"(tid));
        const int wid = __builtin_amdgcn_readfirstlane(tid >> 6), lane = tid & 63, fr = lane & 15, fq = lane >> 4;
        const int bh = task & 63, cs = task >> 6, c = c_lo + cs, b = bh >> 3, h = bh & 7;
        const int t0 = 64 * c - 48;
        const long rowbase = (long)b * LTOK + t0;
        const int gidx = tid & 15, rs = tid >> 4;
        const bool okl = (t0 + lane) >= 0;
        const float* ab = AB + (size_t)(okl ? rowbase + lane : (long)b * LTOK) * 16;
        const float g0 = ab[h], b0 = ab[8 + h];
        u32x4 raw[3][5]; float mk[5];
#pragma unroll
        for (int r5 = 0; r5 < 5; ++r5) {
            const int ii = 2 * rs - 3 + r5;
            const bool okr = (t0 + ii) >= 0;
            mk[r5] = okr ? 1.f : 0.f;
            const bf16_t* src = (ii >= 0) ? QKV + (size_t)(okr ? rowbase + ii : (long)b * LTOK) * 3072 + h * 128 + gidx * 8 : HALO + ((size_t)((b * 65 + c) * 3 + (ii + 3))) * 3072 + h * 128 + gidx * 8;
#pragma unroll
            for (int part = 0; part < 3; ++part) raw[part][r5] = *(const u32x4*)(src + part * 1024);
        }
        if (c == 0) {
#pragma unroll
            for (int r5 = 0; r5 < 5; ++r5)
#pragma unroll
                for (int part = 0; part < 3; ++part) if (mk[r5] == 0.f) raw[part][r5] = (u32x4){0u, 0u, 0u, 0u};
        }
        if (h != h_loaded) {
#pragma unroll
            for (int q = 0; q < 3; ++q) { const int n = tid + 512 * q, part = n >> 9, j = (n >> 7) & 3, cc = n & 127; CW[n] = p.dn_conv_w[((size_t)l * 4 + j) * 3072 + part * 1024 + h * 128 + cc]; }
            h_loaded = h;
            __syncthreads();
        }
        float gsc = okl ? g0 : 0.f, bsc = okl ? b0 : 0.f;
#pragma unroll
        for (int off = 1; off < 64; off <<= 1) { const float v = __shfl_up(gsc, off); if (lane >= off) gsc += v; }
        if (wid == 0) {
            GS[lane] = gsc; BS[lane] = bsc;
            if (lane == 63 && !dry) GLAST[bh * 65 + c] = __expf(gsc);
        }
        float qreg[2][8], rv[2][8], rk[2][8];
        const float glast = __shfl(gsc, 63);
#pragma unroll
        for (int pp = 0; pp < 2; ++pp) {
            const int i = 2 * rs + pp; const bool valid = (t0 + i) >= 0;
            const float Gi = __shfl(gsc, i), bi = __shfl(bsc, i);
            float y[3][8];
#pragma unroll
            for (int part = 0; part < 3; ++part) {
                const int col = part * 1024 + h * 128 + gidx * 8;
                float a[8];
#pragma unroll
                for (int e = 0; e < 8; ++e) a[e] = 0.f;
#pragma unroll
                for (int j = 0; j < 4; ++j) {
                    const u32x4 rw = raw[part][pp + j];
                    const LAS float* cw = CW + (part * 4 + j) * 128 + gidx * 8;
                    const f32x4 w0 = *(const LAS f32x4*)cw, w1 = *(const LAS f32x4*)(cw + 4);
                    a[0] += w0[0] * bf_lo(rw[0]); a[1] += w0[1] * bf_hi(rw[0]); a[2] += w0[2] * bf_lo(rw[1]); a[3] += w0[3] * bf_hi(rw[1]);
                    a[4] += w1[0] * bf_lo(rw[2]); a[5] += w1[1] * bf_hi(rw[2]); a[6] += w1[2] * bf_lo(rw[3]); a[7] += w1[3] * bf_hi(rw[3]);
                }
#pragma unroll
                for (int e = 0; e < 8; ++e) y[part][e] = valid ? silu_f(a[e]) : 0.f;

            }
            float sq = 0.f, sk = 0.f;
#pragma unroll
            for (int e = 0; e < 8; ++e) { sq += y[0][e] * y[0][e]; sk += y[1][e] * y[1][e]; }
#pragma unroll
            for (int o = 1; o < 16; o <<= 1) { sq += __shfl_xor(sq, o); sk += __shfl_xor(sk, o); }
            const float iq = rsqrtf(sq + EPS) * 0.08838834764831845f, ik = rsqrtf(sk + EPS);
            const float eg = __expf(Gi), egl = __expf(glast - Gi);
            float qv[8], kv[8];
#pragma unroll
            for (int e = 0; e < 8; ++e) { qv[e] = y[0][e] * iq; kv[e] = y[1][e] * ik; qreg[pp][e] = qv[e] * eg; }
            u32x4 pk, pq;
            pk[0] = cvt_pk_bf16(kv[0], kv[1]); pk[1] = cvt_pk_bf16(kv[2], kv[3]); pk[2] = cvt_pk_bf16(kv[4], kv[5]); pk[3] = cvt_pk_bf16(kv[6], kv[7]);
            pq[0] = cvt_pk_bf16(qv[0], qv[1]); pq[1] = cvt_pk_bf16(qv[2], qv[3]); pq[2] = cvt_pk_bf16(qv[4], qv[5]); pq[3] = cvt_pk_bf16(qv[6], qv[7]);
            *(LAS u32x4*)(KB + img128_byte(i, gidx * 8)) = pk;
            *(LAS u32x4*)(QB + img128_byte(i, gidx * 8)) = pq;
            const float bk = bi * eg;
#pragma unroll
            for (int e = 0; e < 8; ++e) { rv[pp][e] = bi * y[2][e]; rk[pp][e] = bk * kv[e]; }
            u32x4 pd;
            pd[0] = cvt_pk_bf16(kv[0] * egl, kv[1] * egl); pd[1] = cvt_pk_bf16(kv[2] * egl, kv[3] * egl); pd[2] = cvt_pk_bf16(kv[4] * egl, kv[5] * egl); pd[3] = cvt_pk_bf16(kv[6] * egl, kv[7] * egl);
            *(LAS u32x4*)(KDS + i * 136 + gidx * 8) = pd;
        }
#pragma unroll
        for (int e = 0; e < 8; ++e) {
            const int jv = gidx * 8 + e;
            *(LAS unsigned*)(RT + img64_byte(jv, 2 * rs)) = cvt_pk_bf16(rv[0][e], rv[1][e]);
            *(LAS unsigned*)(RT + img64_byte(128 + jv, 2 * rs)) = cvt_pk_bf16(rk[0][e], rk[1][e]);
        }
        __syncthreads();
#pragma unroll
        for (int pp = 0; pp < 2; ++pp) {
            const int i = 2 * rs + pp;
            if (t0 + i >= 0 && !dry) {
                u32x4 o; o[0] = cvt_pk_bf16(qreg[pp][0], qreg[pp][1]); o[1] = cvt_pk_bf16(qreg[pp][2], qreg[pp][3]); o[2] = cvt_pk_bf16(qreg[pp][4], qreg[pp][5]); o[3] = cvt_pk_bf16(qreg[pp][6], qreg[pp][7]);
                *(u32x4*)(QKV + (size_t)(rowbase + i) * 3072 + h * 128 + ((gidx ^ (i & 15)) << 3)) = o;
            }
        }
        {
#pragma unroll
            for (int k3 = 0; k3 < 3; ++k3) {
                const int idx = wid + 8 * k3;
                if (idx < 20) {
                    const int mat = idx >= 10 ? 1 : 0, k = idx - 10 * mat;
                    const int rt = (k >= 6) ? 3 : (k >= 3) ? 2 : (k >= 1) ? 1 : 0, ct = k - rt * (rt + 1) / 2;
                    LAS unsigned char* Ab = mat == 0 ? KB : QB;
                    f32x4 acc = (f32x4){0.f, 0.f, 0.f, 0.f};
#pragma unroll
                    for (int ks = 0; ks < 4; ++ks) {
                        const bf16x8 af = *(const LAS bf16x8*)(Ab + img128_byte(16 * rt + fr, 32 * ks + 8 * fq));
                        const bf16x8 bf = *(const LAS bf16x8*)(KB + img128_byte(16 * ct + fr, 32 * ks + 8 * fq));
                        acc = __builtin_amdgcn_mfma_f32_16x16x32_bf16(af, bf, acc, 0, 0, 0);
                    }
                    const int j = 16 * ct + fr; const float Gj = GS[j];
#pragma unroll
                    for (int rg = 0; rg < 4; ++rg) {
                        const int i = 16 * rt + 4 * fq + rg;
                        const float dec = __expf(fminf(GS[i] - Gj, 0.f));
                        if (mat == 0) {
                            const float av_ = (i > j) ? BS[i] * acc[rg] * dec : 0.f;
                            AM[i * 64 + j] = av_;
                            if (rt >= 2 && ct < 2) *(LAS bf16_t*)(OUTS + (i - 32) * 64 + j * 2) = f2bf(av_);
                        }
                        else *(LAS bf16_t*)(PS + img64_byte(i, j)) = f2bf((i >= j) ? acc[rg] * dec : 0.f);
                    }
                }
            }
            if (wid < 6) {
                const int rt = (wid < 3) ? 0 : (wid < 5) ? 1 : 2, ct = (wid < 3) ? wid + 1 : (wid < 5) ? wid - 1 : 3;
                const int j = 16 * ct + fr;
#pragma unroll
                for (int rg = 0; rg < 4; ++rg) *(LAS bf16_t*)(PS + img64_byte(16 * rt + 4 * fq + rg, j)) = (bf16_t)0;
            }
        }
        __syncthreads();
        if (wid == 0) {
            const int hi = lane >> 5, cl = lane & 31;
            const LAS float* Ab = AM + hi * (32 * 64 + 32);
            LAS unsigned char* A21I = OUTS; LAS unsigned char* XT11 = OUTS + 2048; LAS unsigned char* YT = OUTS + 4096;
            f32x2 xp[16];
            f32x4 abuf[2][8];
            abuf[1][0] = *(const LAS f32x4*)(Ab + 64);
#pragma unroll
            for (int i = 0; i < 32; ++i) {
                if (i + 1 < 32 && i + 1 >= 2) {
#pragma unroll
                    for (int g = 0; g < (i + 1 + 3) / 4; ++g) abuf[(i + 1) & 1][g] = *(const LAS f32x4*)(Ab + (i + 1) * 64 + g * 4);
                }
                __builtin_amdgcn_sched_barrier(0);
                f32x2 a0 = (f32x2){0.f, 0.f}, a1 = (f32x2){0.f, 0.f}; float tl = 0.f;
#pragma unroll
                for (int g = 0; g < (i + 3) / 4; ++g) {
                    const f32x4 av = abuf[i & 1][g];
                    if (4 * g + 1 < i) a0 += (f32x2){av[0], av[1]} * xp[2 * g];
                    else if (4 * g < i) tl += av[0] * xp[2 * g][0];
                    if (4 * g + 3 < i) a1 += (f32x2){av[2], av[3]} * xp[2 * g + 1];
                    else if (4 * g + 2 < i) tl += av[2] * xp[2 * g + 1][0];
                }
                float xi = ((i == cl) ? 1.f : 0.f) - (((a0[0] + a0[1]) + (a1[0] + a1[1])) + tl);
                asm volatile("" : "+v"(xi));
                if (i & 1) xp[i >> 1][1] = xi; else { xp[i >> 1][0] = xi; xp[i >> 1][1] = 0.f; }
                __builtin_amdgcn_sched_barrier(0);
            }
#pragma unroll
            for (int i = 0; i < 32; ++i) {
                int lo = lane; asm volatile("" : "+v"(lo));
                *(LAS bf16_t*)(XI + img64_byte(32 * (lo >> 5) + i, lo)) = f2bf(xp[i >> 1][i & 1]);
                if (lo >> 5) *(LAS bf16_t*)(XI + img64_byte(i, lo)) = (bf16_t)0;
            }
            if (!hi) {
#pragma unroll
                for (int q = 0; q < 16; ++q) *(LAS unsigned*)(XT11 + cl * 64 + q * 4) = cvt_pk_bf16(xp[q][0], xp[q][1]);
            }
#pragma unroll
            for (int rtp = 0; rtp < 2; ++rtp)
#pragma unroll
                for (int ctp = 0; ctp < 2; ++ctp) {
                    const bf16x8 afr = *(const LAS bf16x8*)(A21I + (16 * rtp + fr) * 64 + fq * 16);
                    const bf16x8 bfr2 = *(const LAS bf16x8*)(XT11 + (16 * ctp + fr) * 64 + fq * 16);
                    const f32x4 yv = __builtin_amdgcn_mfma_f32_16x16x32_bf16(afr, bfr2, (f32x4){0.f, 0.f, 0.f, 0.f}, 0, 0, 0);
                    u32x2 o; o[0] = cvt_pk_bf16(yv[0], yv[1]); o[1] = cvt_pk_bf16(yv[2], yv[3]);
                    *(LAS u32x2*)(YT + (16 * ctp + fr) * 64 + (16 * rtp + 4 * fq) * 2) = o;
                }
#pragma unroll
            for (int rtp = 0; rtp < 2; ++rtp)
#pragma unroll
                for (int ctp = 0; ctp < 2; ++ctp) {
                    const bf16x8 afr = *(const LAS bf16x8*)(XI + img64_byte(32 + 16 * rtp + fr, 32 + 8 * fq));
                    const bf16x8 bfr2 = *(const LAS bf16x8*)(YT + (16 * ctp + fr) * 64 + fq * 16);
                    const f32x4 xv = __builtin_amdgcn_mfma_f32_16x16x32_bf16(afr, bfr2, (f32x4){0.f, 0.f, 0.f, 0.f}, 0, 0, 0);
#pragma unroll
                    for (int rg = 0; rg < 4; ++rg) *(LAS bf16_t*)(XI + img64_byte(32 + 16 * rtp + 4 * fq + rg, 16 * ctp + fr)) = f2bf(-xv[rg]);
                }
        } else {
            unsigned char* kdt = p.ws + OFF_KDT + (size_t)(bh * SEG0 + cs) * 16384;
#pragma unroll
            for (int pp = 0; pp < 3; ++pp) {
                const int id = (tid - 64) + 448 * pp;
                if (id < 1024) {
                    const int dk = id & 127, ic = id >> 7;
                    unsigned short e[8];
#pragma unroll
                    for (int q = 0; q < 8; ++q) e[q] = KDS[(8 * ic + q) * 136 + dk];
                    u32x4 o; o[0] = e[0] | ((unsigned)e[1] << 16); o[1] = e[2] | ((unsigned)e[3] << 16); o[2] = e[4] | ((unsigned)e[5] << 16); o[3] = e[6] | ((unsigned)e[7] << 16);
                    if (!dry) *(u32x4*)(kdt + dk * 128 + ((ic ^ ((dk >> 1) & 7)) << 4)) = o;
                }
            }
            if (tid >= 256) {
                unsigned char* pim = p.ws + OFF_PIMG + (size_t)(bh * SEG0 + cs) * 8192;
#pragma unroll
                for (int pp = 0; pp < 2; ++pp) { const int id = (tid - 256) + 256 * pp; if (!dry) *(u32x4*)(pim + id * 16) = *(const LAS u32x4*)(PS + id * 16); }
            }
        }
        __syncthreads();
        {
            bf16x8 af[4][2], bfr[2][2];
#pragma unroll
            for (int rt = 0; rt < 4; ++rt)
#pragma unroll
                for (int ks = 0; ks < 2; ++ks) af[rt][ks] = *(const LAS bf16x8*)(XI + img64_byte(16 * rt + fr, 32 * ks + 8 * fq));
#pragma unroll
            for (int jj = 0; jj < 2; ++jj)
#pragma unroll
                for (int ks = 0; ks < 2; ++ks) bfr[jj][ks] = *(const LAS bf16x8*)(RT + img64_byte(16 * (2 * wid + jj) + fr, 32 * ks + 8 * fq));
#pragma unroll
            for (int rt = 0; rt < 4; ++rt)
#pragma unroll
                for (int jj = 0; jj < 2; ++jj) {
                    f32x4 acc = (f32x4){0.f, 0.f, 0.f, 0.f};
#pragma unroll
                    for (int ks = 0; ks < 2; ++ks) acc = __builtin_amdgcn_mfma_f32_16x16x32_bf16(af[rt][ks], bfr[jj][ks], acc, 0, 0, 0);
                    const int jc = 16 * (2 * wid + jj) + fr;
#pragma unroll
                    for (int rg = 0; rg < 4; ++rg) *(LAS bf16_t*)(OUTS + (16 * rt + 4 * fq + rg) * 512 + jc * 2) = f2bf(acc[rg]);
                }
        }
        __syncthreads();
        {
            const int i_lo = dry ? 64 : (t0 < 0 ? -t0 : 0);
#pragma unroll
            for (int q = 0; q < 4; ++q) {
                const int id = tid + 512 * q, half = id >> 10, rem = id & 1023, i = rem >> 4, ch = rem & 15;
                const u32x4 o = *(const LAS u32x4*)(OUTS + i * 512 + half * 256 + ch * 16);
                if (i >= i_lo) *(u32x4*)(QKV + (size_t)(rowbase + i) * 3072 + (half ? 1024 : 2048) + h * 128 + ((half ? (ch ^ (i & 15)) : ch) << 3)) = o;
            }
        }
        __syncthreads();
    }
}

struct BRegs { bf16x8 ay[4], ap[2], ak[2]; unsigned u[2][4]; float gl; };
__device__ __forceinline__ void stage_b(const Params& p, int seg, LAS unsigned char* lds, const bool dry = false) {
    int tid = threadIdx.x; asm volatile("" : "+v"(tid));
    const int wid = __builtin_amdgcn_readfirstlane(tid >> 6), lane = tid & 63, fr = lane & 15, fq = lane >> 4;
    bf16_t* QKV = (bf16_t*)(p.ws + OFF_QKV); const float* GLAST = (const float*)(p.ws + OFF_GLAST); float* SSAVE = (float*)(p.ws + OFF_SSAVE);
    LAS unsigned char* STL = lds; LAS unsigned char* VNTL = lds + 8192;
    const int nch = seg == 0 ? SEG0 : NCH - SEG0, c_lo = seg == 0 ? 0 : SEG0;
    const bf16x8 zero8 = (bf16x8){0, 0, 0, 0, 0, 0, 0, 0};
    for (int wk = blockIdx.x; wk < 256; wk += gridDim.x) {
        const int bh = (wk & 7) + 8 * (wk >> 5), sl = (wk >> 3) & 3, b = bh >> 3, h = bh & 7;
        f32x4 accS[2];
        if (seg == 0) { accS[0] = (f32x4){0.f, 0.f, 0.f, 0.f}; accS[1] = accS[0]; }
        else { accS[0] = *(const f32x4*)(SSAVE + ((size_t)wk * 512 + tid) * 8); accS[1] = *(const f32x4*)(SSAVE + ((size_t)wk * 512 + tid) * 8 + 4); }
#pragma unroll
        for (int ct = 0; ct < 2; ++ct) { u32x2 o; o[0] = cvt_pk_bf16(accS[ct][0], accS[ct][1]); o[1] = cvt_pk_bf16(accS[ct][2], accS[ct][3]); *(LAS u32x2*)(STL + img128_byte(16 * ct + fr, 16 * wid + 4 * fq)) = o; }
        const int yrow = 16 * (wid & 3) + fr;
        auto issue_y = [&](int cs_, BRegs& R) {
            {
                const int cs = cs_ < nch ? cs_ : nch - 1;
                const int c = c_lo + cs, t0 = 64 * c - 48;
                const long rowbase = (long)b * LTOK + t0;
                const bool valid = t0 + yrow >= 0;
                const bf16_t* rp = QKV + (size_t)(valid ? rowbase + yrow : (long)b * LTOK) * 3072 + (wid < 4 ? 1024 : 0) + h * 128;
#pragma unroll
                for (int ks = 0; ks < 4; ++ks) R.ay[ks] = *(const bf16x8*)(rp + (((4 * ks + fq) ^ (yrow & 15)) << 3));
                if (wid < 4) {
#pragma unroll
                    for (int ct = 0; ct < 2; ++ct)
#pragma unroll
                        for (int rg = 0; rg < 4; ++rg) {
                            const int i = 16 * wid + 4 * fq + rg;
                            const bool okr = (t0 + i) >= 0;
                            R.u[ct][rg] = QKV[(size_t)(okr ? rowbase + i : (long)b * LTOK) * 3072 + 2048 + h * 128 + sl * 32 + 16 * ct + fr];
                        }
                }
                R.gl = GLAST[bh * 65 + c];
            }
        };
        auto issue_rest = [&](int cs_, BRegs& R) {
            {
                const int cs = cs_ < nch ? cs_ : nch - 1;
                const unsigned char* kdt = p.ws + OFF_KDT + (size_t)(bh * SEG0 + cs) * 16384;
                const unsigned char* pim = p.ws + OFF_PIMG + (size_t)(bh * SEG0 + cs) * 8192;
                const int dk = 16 * wid + fr;
#pragma unroll
                for (int ks = 0; ks < 2; ++ks) R.ak[ks] = *(const bf16x8*)(kdt + dk * 128 + (((4 * ks + fq) ^ ((dk >> 1) & 7)) << 4));
                if (wid >= 4) {
                    const int pi = 16 * (wid - 4) + fr;
#pragma unroll
                    for (int ks = 0; ks < 2; ++ks) R.ap[ks] = *(const bf16x8*)(pim + pi * 128 + (((4 * ks + fq) ^ ((pi >> 1) & 7)) << 4));
                }
            }
        };
        auto body = [&](int cs, BRegs& R) {
            const int c = c_lo + cs, t0 = 64 * c - 48;
            const long rowbase = (long)b * LTOK + t0;
            float uu[2][4];
#pragma unroll
            for (int ct = 0; ct < 2; ++ct)
#pragma unroll
                for (int rg = 0; rg < 4; ++rg) uu[ct][rg] = (t0 + 16 * wid + 4 * fq + rg >= 0) ? __uint_as_float(R.u[ct][rg] << 16) : 0.f;
            const bool yvalid = t0 + yrow >= 0;
            const float gl = R.gl;
            asm volatile("s_waitcnt lgkmcnt(0)" ::: "memory"); __builtin_amdgcn_s_barrier(); asm volatile("" ::: "memory");
            f32x4 accY[2]; accY[0] = (f32x4){0.f, 0.f, 0.f, 0.f}; accY[1] = accY[0];
            bf16x8 bfy[4][2];
#pragma unroll
            for (int ks = 0; ks < 4; ++ks)
#pragma unroll
                for (int ct = 0; ct < 2; ++ct) bfy[ks][ct] = *(const LAS bf16x8*)(STL + img128_byte(16 * ct + fr, 32 * ks + 8 * fq));
#pragma unroll
            for (int ks = 0; ks < 4; ++ks) {
#pragma unroll
                for (int ct = 0; ct < 2; ++ct) accY[ct] = __builtin_amdgcn_mfma_f32_16x16x32_bf16(yvalid ? R.ay[ks] : zero8, bfy[ks][ct], accY[ct], 0, 0, 0);
            }
            if (wid < 4) {
#pragma unroll
                for (int ct = 0; ct < 2; ++ct) {
                    u32x2 o; o[0] = cvt_pk_bf16(uu[ct][0] - accY[ct][0], uu[ct][1] - accY[ct][1]); o[1] = cvt_pk_bf16(uu[ct][2] - accY[ct][2], uu[ct][3] - accY[ct][3]);
                    *(LAS u32x2*)(VNTL + img64_byte(16 * ct + fr, 16 * wid + 4 * fq)) = o;
                }
            }
            issue_y(cs + 2, R);
            asm volatile("s_waitcnt lgkmcnt(0)" ::: "memory"); __builtin_amdgcn_s_barrier(); asm volatile("" ::: "memory");
            bf16x8 bfv[2][2];
#pragma unroll
            for (int ks = 0; ks < 2; ++ks)
#pragma unroll
                for (int ct = 0; ct < 2; ++ct) bfv[ks][ct] = *(const LAS bf16x8*)(VNTL + img64_byte(16 * ct + fr, 32 * ks + 8 * fq));
            if (wid >= 4) {
                const int rt = wid - 4;
#pragma unroll
                for (int ks = 0; ks < 2; ++ks) {
#pragma unroll
                    for (int ct = 0; ct < 2; ++ct) accY[ct] = __builtin_amdgcn_mfma_f32_16x16x32_bf16(R.ap[ks], bfv[ks][ct], accY[ct], 0, 0, 0);
                }
#pragma unroll
                for (int ct = 0; ct < 2; ++ct)
#pragma unroll
                    for (int rg = 0; rg < 4; ++rg) {
                        const int i = 16 * rt + 4 * fq + rg;
                        if (t0 + i >= 0 && !dry) QKV[(size_t)(rowbase + i) * 3072 + 2048 + h * 128 + sl * 32 + 16 * ct + fr] = f2bf(accY[ct][rg]);
                    }
            }
            accS[0] *= gl; accS[1] *= gl;
#pragma unroll
            for (int ks = 0; ks < 2; ++ks) {
#pragma unroll
                for (int ct = 0; ct < 2; ++ct) accS[ct] = __builtin_amdgcn_mfma_f32_16x16x32_bf16(R.ak[ks], bfv[ks][ct], accS[ct], 0, 0, 0);
            }
#pragma unroll
            for (int ct = 0; ct < 2; ++ct) { u32x2 o; o[0] = cvt_pk_bf16(accS[ct][0], accS[ct][1]); o[1] = cvt_pk_bf16(accS[ct][2], accS[ct][3]); *(LAS u32x2*)(STL + img128_byte(16 * ct + fr, 16 * wid + 4 * fq)) = o; }
            issue_rest(cs + 2, R);
        };
        BRegs R0, R1;
        issue_y(0, R0); issue_rest(0, R0); issue_y(1, R1); issue_rest(1, R1);
        for (int cs = 0; cs < nch; cs += 2) {
            body(cs, R0);
            if (cs + 1 < nch) body(cs + 1, R1);
        }
        __syncthreads();
        if (seg == 0 && !dry) { *(f32x4*)(SSAVE + ((size_t)wk * 512 + tid) * 8) = accS[0]; *(f32x4*)(SSAVE + ((size_t)wk * 512 + tid) * 8 + 4) = accS[1]; }
    }
}

__device__ __forceinline__ void phase_mix(const Params& p, int l, const bool dry = false) {
    int tid = threadIdx.x; asm volatile("" : "+v"(tid));
    const int wid = tid >> 6, lane = tid & 63;
    const int gw = blockIdx.x * 8 + wid, nw = gridDim.x * 8;
    const bf16_t* QKV = (const bf16_t*)(p.ws + OFF_QKV); bf16_t* ZG = (bf16_t*)(p.ws + OFF_ZG); const bf16_t* U = (const bf16_t*)(p.ws + OFF_U);
    const float* og = p.out_g + (size_t)l * 128 + (lane & 7) * 16;
    const float* cw = p.sc_conv_w + (size_t)l * 3 * 1024 + lane * 16;
    float ogr[16];
#pragma unroll
    for (int e = 0; e < 16; ++e) ogr[e] = og[e];
    for (int rb = gw * 4; rb < MROWS; rb += nw * 4) {
        u32x4 ov[4][2], zv[4][2];
#pragma unroll
        for (int k = 0; k < 4; ++k) {
            const size_t r = (size_t)(rb + k);
            ov[k][0] = *(const u32x4*)(QKV + r * 3072 + 2048 + lane * 16); ov[k][1] = *(const u32x4*)(QKV + r * 3072 + 2048 + lane * 16 + 8);
            zv[k][0] = *(const u32x4*)(ZG + r * 2048 + lane * 16); zv[k][1] = *(const u32x4*)(ZG + r * 2048 + lane * 16 + 8);
        }
#pragma unroll
        for (int k = 0; k < 4; ++k) {
            const size_t r = (size_t)(rb + k);
            float o[16], z[16];
#pragma unroll
            for (int q = 0; q < 4; ++q) { o[2 * q] = bf_lo(ov[k][0][q]); o[2 * q + 1] = bf_hi(ov[k][0][q]); o[8 + 2 * q] = bf_lo(ov[k][1][q]); o[8 + 2 * q + 1] = bf_hi(ov[k][1][q]);
                z[2 * q] = bf_lo(zv[k][0][q]); z[2 * q + 1] = bf_hi(zv[k][0][q]); z[8 + 2 * q] = bf_lo(zv[k][1][q]); z[8 + 2 * q + 1] = bf_hi(zv[k][1][q]); }
            float ss = 0.f;
#pragma unroll
            for (int e = 0; e < 16; ++e) ss += o[e] * o[e];
            ss += __shfl_xor(ss, 1); ss += __shfl_xor(ss, 2); ss += __shfl_xor(ss, 4);
            const float rstd = rsqrtf(ss * (1.f / 128.f) + EPS);
            float y[16];
#pragma unroll
            for (int e = 0; e < 16; ++e) y[e] = o[e] * rstd * ogr[e] * silu_f(z[e]);
            u32x4 w0, w1;
#pragma unroll
            for (int q = 0; q < 4; ++q) { w0[q] = cvt_pk_bf16(y[2 * q], y[2 * q + 1]); w1[q] = cvt_pk_bf16(y[8 + 2 * q], y[8 + 2 * q + 1]); }
            if (!dry) { *(u32x4*)(ZG + r * 2048 + lane * 16) = w0; *(u32x4*)(ZG + r * 2048 + lane * 16 + 8) = w1; }
        }
    }
    const bf16_t* UH = U; const bf16_t* GH = U + (size_t)2 * 1024 * 1024;
    for (int it = gw; it < 2 * (MPAD / 64); it += nw) {
        const int kb = it >> 1, which = it & 1, r = 64 * kb + which;
        if (kb >= 1 && r < MROWS) {
            const int b = r / LTOK, t = r - b * LTOK;
            const bf16_t* um2p = UH + ((size_t)(kb - 1) * 2 + (which ? 1 : 0)) * 1024 + lane * 16;
            const bf16_t* um1p = UH + ((size_t)(kb - 1) * 2 + 1) * 1024 + lane * 16;
            const bf16_t* gp = GH + ((size_t)kb * 2 + which) * 1024 + lane * 16;
            bf16_t* yp = ZG + (size_t)r * 2048 + 1024 + lane * 16;
            const float m2 = (t >= 2) ? 1.f : 0.f, m1 = (which == 0 && t >= 1) ? 1.f : 0.f;
#pragma unroll
            for (int hh = 0; hh < 2; ++hh) {
                const u32x4 a2 = *(const u32x4*)(um2p + 8 * hh), a1 = *(const u32x4*)(um1p + 8 * hh), gg = *(const u32x4*)(gp + 8 * hh), yy = *(const u32x4*)(yp + 8 * hh);
                u32x4 o;
#pragma unroll
                for (int q = 0; q < 4; ++q) {
                    const int e = 8 * hh + 2 * q;
                    const float c0 = bf_lo(gg[q]) * (m2 * cw[e] * bf_lo(a2[q]) + m1 * cw[1024 + e] * bf_lo(a1[q]));
                    const float c1 = bf_hi(gg[q]) * (m2 * cw[e + 1] * bf_hi(a2[q]) + m1 * cw[1024 + e + 1] * bf_hi(a1[q]));
                    o[q] = cvt_pk_bf16(bf_lo(yy[q]) + c0, bf_hi(yy[q]) + c1);
                }
                if (!dry) *(u32x4*)(yp + 8 * hh) = o;
            }
        }
    }
}

__device__ __forceinline__ void phase_final(const Params& p) {
    int tid = threadIdx.x; asm volatile("" : "+v"(tid));
    const int wid = tid >> 6, lane = tid & 63;
    const int gw = blockIdx.x * 8 + wid, nw = gridDim.x * 8;
    for (int r = gw; r < 8 * 4096; r += nw) {
        float* s = p.out + (size_t)r * 1024;
        f32x4 v[4]; float ss = 0.f;
#pragma unroll
        for (int q = 0; q < 4; ++q) { v[q] = *(const f32x4*)(s + lane * 4 + 256 * q); ss += v[q][0] * v[q][0] + v[q][1] * v[q][1] + v[q][2] * v[q][2] + v[q][3] * v[q][3]; }
#pragma unroll
        for (int o = 32; o >= 1; o >>= 1) ss += __shfl_xor(ss, o);
        const float rstd = rsqrtf(ss * (1.f / 1024.f) + EPS);
#pragma unroll
        for (int q = 0; q < 4; ++q) { const f32x4 gq = *(const f32x4*)(p.final_g + lane * 4 + 256 * q); *(f32x4*)(s + lane * 4 + 256 * q) = v[q] * rstd * gq; }
    }
}

#define XB_TMO      128
#define XB_XCNT(j)  (256  + 64 * (j))
#define XB_XSUB(j)  (1280 + 64 * (j))
#define XB_XGEN(j)  (2304 + 64 * (j))
#define XB_TOP      3328
#define XB_TOPGEN   3392
#define XCD_BAR_WORDS 3456
#define XB_SPIN_CAP (1u << 24)
__device__ __forceinline__ unsigned xb_ld(unsigned* p)              { return __hip_atomic_load(p, __ATOMIC_RELAXED, __HIP_MEMORY_SCOPE_AGENT); }
__device__ __forceinline__ unsigned xb_add(unsigned* p, unsigned v) { return __hip_atomic_fetch_add(p, v, __ATOMIC_RELAXED, __HIP_MEMORY_SCOPE_AGENT); }
__device__ __forceinline__ unsigned xb_xcc_id() { return (unsigned)__builtin_amdgcn_s_getreg((3 << 11) | 20) & 0xFu; }
#define XB_SPIN(cond, bar) do { unsigned _sp = 0; while (cond) { __builtin_amdgcn_s_sleep(1); \
    if ((++_sp & 255u) == 0u) { if (xb_ld(&(bar)[XB_TMO])) break; if (_sp > XB_SPIN_CAP) { atomicAdd(&(bar)[XB_TMO], 1u); break; } } } } while (0)
struct XcdBarrier { unsigned* bar; unsigned x; volatile LAS unsigned* st; };
__device__ __forceinline__ XcdBarrier xcd_barrier_post(unsigned* bar, volatile LAS unsigned* st) {
    XcdBarrier b; b.bar = bar; b.x = xb_xcc_id(); b.st = st;
    if (threadIdx.x == 0) (void)xb_add(&bar[XB_XCNT(b.x)], 1u);
    return b;
}
__device__ __forceinline__ void xcd_barrier_complete(unsigned* bar, unsigned x, unsigned& nloc, unsigned& nx) {
    const unsigned G = gridDim.x * gridDim.y * gridDim.z;
    unsigned sum, cnt, mine, sp = 0u;
    for (;;) {
        sum = 0u; cnt = 0u; mine = 0u;
#pragma unroll
        for (unsigned j = 0; j < 16; ++j) { const unsigned c = xb_ld(&bar[XB_XCNT(j)]); sum += c; cnt += (c > 0u) ? 1u : 0u; mine = (j == x) ? c : mine; }
        if (sum == G) break;
        __builtin_amdgcn_s_sleep(1);
        if ((++sp & 255u) == 0u) { if (xb_ld(&bar[XB_TMO])) break; if (sp > XB_SPIN_CAP) { atomicAdd(&bar[XB_TMO], 1u); break; } }
    }
    nloc = mine > 0u ? mine : 1u; nx = cnt > 0u ? cnt : 1u;
}
__device__ __forceinline__ void xcd_barrier(const XcdBarrier& b) {
    asm volatile("s_waitcnt vmcnt(0)" ::: "memory");
    __syncthreads();
    if (threadIdx.x == 0) {
        unsigned* bar = b.bar;
        __builtin_amdgcn_s_waitcnt(0);
        unsigned nloc = b.st[0], nx = b.st[1];
        if (nloc == 0u) { xcd_barrier_complete(bar, b.x, nloc, nx); b.st[0] = nloc; b.st[1] = nx; }
        const unsigned old = xb_add(&bar[XB_XSUB(b.x)], 1u);
        const unsigned gen = old / nloc;
        if (old + 1u == (gen + 1u) * nloc) {
            __builtin_amdgcn_fence(__ATOMIC_RELEASE, "agent");
            asm volatile("s_waitcnt vmcnt(0)" ::: "memory");
            const unsigned og = xb_add(&bar[XB_TOP], 1u);
            const unsigned tg = og / nx;
            if (og + 1u == (tg + 1u) * nx) xb_add(&bar[XB_TOPGEN], 1u);
            else XB_SPIN(xb_ld(&bar[XB_TOPGEN]) == tg, bar);
            __builtin_amdgcn_fence(__ATOMIC_ACQUIRE, "agent");
            xb_add(&bar[XB_XGEN(b.x)], 1u);
            asm volatile("s_waitcnt vmcnt(0)" ::: "memory");
        } else {
            XB_SPIN(xb_ld(&bar[XB_XGEN(b.x)]) == gen, bar);
            __builtin_amdgcn_fence(__ATOMIC_ACQUIRE, "agent");
            asm volatile("s_waitcnt vmcnt(0)" ::: "memory");
        }
    }
    __syncthreads();
}

constexpr int N_PHASES = 33;
#ifndef PHM
#define PHM 63
#endif

__global__ void __launch_bounds__(512, 2) mega(Params p) {
    extern __shared__ __attribute__((aligned(16))) unsigned char shm[];
    LAS unsigned char* lds = (LAS unsigned char*)shm;
#ifdef PROBE_SEL
    unsigned long long tprev = __builtin_amdgcn_s_memrealtime(); float tacc[8] = {0.f, 0.f, 0.f, 0.f, 0.f, 0.f, 0.f, 0.f};
#endif
    XcdBarrier xb; xb.bar = (unsigned*)(p.ws + OFF_BAR); xb.x = 0; xb.st = (volatile LAS unsigned*)(lds + LDS_BYTES - 16);
    if (p.ph_hi - p.ph_lo > 1) {
        if (threadIdx.x == 0) { xb.st[0] = 0u; xb.st[1] = 0u; }
        __syncthreads();
        xb = xcd_barrier_post((unsigned*)(p.ws + OFF_BAR), (volatile LAS unsigned*)(lds + LDS_BYTES - 16));
    }
    for (int ph = p.ph_lo; ph < p.ph_hi; ++ph) {
        if (ph == p.ph_lo + 1) cg::this_grid().sync();
        else if (ph > p.ph_lo) xcd_barrier(xb);
#ifdef PROBE_SEL
        if (ph > p.ph_lo) { const unsigned long long tn = __builtin_amdgcn_s_memrealtime(); const float d = (float)(tn - tprev) * 0.01f; tprev = tn; const int ps = (ph - 1) & 7;
#pragma unroll
            for (int q = 0; q < 8; ++q) if (q == ps) tacc[q] += d; }
#endif
        if (ph == 32) { phase_final(p);
#ifdef PROBE_SEL
            __syncthreads();
            if (blockIdx.x == 0 && threadIdx.x == 0) {
                float a, b;
                if (PROBE_SEL == 0) { a = tacc[2] + tacc[4]; b = tacc[3] + tacc[5]; }
                else if (PROBE_SEL == 1) { a = tacc[1]; b = tacc[7]; }
                else { a = tacc[0]; b = tacc[6]; }
                p.out[0] = a; p.out[1024] = b;
            }
#endif
            continue; }
        const int l = ph >> 3, s = ph & 7;
#ifdef DUPSEL
        if ((DUPSEL >> s) & 1) {
            if (s == 0) phase_prep(p, l);
            else if (s == 2 || s == 4) stage_a(p, l, s == 4 ? 1 : 0, lds, true);
            else if (s == 3 || s == 5) stage_b(p, s == 5 ? 1 : 0, lds, true);
            else if (s == 6) phase_mix(p, l, true);
            cg::this_grid().sync();
        }
#endif
        if (s == 0) { if (PHM & 1) phase_prep(p, l); }
        else if (s == 1) { if (PHM & 2) {
            pg8::Gemm g; g.A = (const bf16_t*)(p.ws + OFF_X); g.Bt = (const bf16_t*)(p.ws + OFF_WIN); g.M = MPAD; g.N = N1; g.K = 1024;
            pg8::StaticOrder<false> S; S.init(MPAD, N1, 1024, gridDim.x, blockIdx.x);
            Epi1 E; E.QKV = (bf16_t*)(p.ws + OFF_QKV); E.ZG = (bf16_t*)(p.ws + OFF_ZG); E.U = (bf16_t*)(p.ws + OFF_U); E.AB = (float*)(p.ws + OFF_AB); E.HALO = (bf16_t*)(p.ws + OFF_HALO);
            E.A_log = p.A_log + l * 8; E.dt_bias = p.dt_bias + l * 8; E.scw = p.sc_conv_w + (size_t)l * 3 * 1024;
            pg8::gemm_phase(lds, g, S, E); }
        }
        else if (s == 2 || s == 4) { if (PHM & 4) stage_a(p, l, s == 4 ? 1 : 0, lds); }
        else if (s == 3 || s == 5) { if (PHM & 8) stage_b(p, s == 5 ? 1 : 0, lds); }
        else if (s == 6) { if (PHM & 16) phase_mix(p, l); }
        else if (PHM & 32) {
            pg8::Gemm g; g.A = (const bf16_t*)(p.ws + OFF_ZG); g.Bt = (const bf16_t*)(p.ws + OFF_WOUT); g.M = MPAD; g.N = 1024; g.K = 2048;
            pg8::StaticOrder<true> S; S.init(MPAD - 256, 1024, 2048, gridDim.x, blockIdx.x);
            Epi2 E; E.src_real = (l == 0) ? p.x : (const float*)p.out; E.src_meta = (l == 0) ? p.meta : (const float*)(p.ws + OFF_HMETA); E.meta_bstride = (l == 0) ? 0 : 16;
            E.dst_real = p.out; E.dst_meta = (float*)(p.ws + OFF_HMETA);
            pg8::gemm_phase(lds, g, S, E);
        }
    }
}

extern "C" void kernel_launch(void* const* d_in, const int* in_sizes, int n_in, void* d_out, int out_size, void* d_ws, size_t ws_size, hipStream_t stream) {
    static int grid = 0;
    if (grid == 0) {
        if (n_in != 11 || ws_size < WS_END2) { fprintf(stderr, "kernel_launch: bad inputs / workspace (%zu < %zu)\n", ws_size, (size_t)WS_END2); grid = -1; return; }
        int dev = 0, cus = 0, per_cu = 0;
        hipGetDevice(&dev);
        hipDeviceGetAttribute(&cus, hipDeviceAttributeMultiprocessorCount, dev);
        hipFuncSetAttribute((const void*)mega, hipFuncAttributeMaxDynamicSharedMemorySize, LDS_BYTES);
        hipOccupancyMaxActiveBlocksPerMultiprocessor(&per_cu, (const void*)mega, 512, LDS_BYTES);
        if (per_cu < 1) per_cu = 1;
        if (per_cu > 1) per_cu = 1;
        grid = cus * per_cu;
        (void)hipGetLastError();
    }
    if (grid < 0) return;
    Params p{};
    p.x = (const float*)d_in[0]; p.meta = (const float*)d_in[1]; p.norm_g = (const float*)d_in[2]; p.w_in = (const float*)d_in[3]; p.dn_conv_w = (const float*)d_in[4];
    p.A_log = (const float*)d_in[5]; p.dt_bias = (const float*)d_in[6]; p.out_g = (const float*)d_in[7]; p.sc_conv_w = (const float*)d_in[8]; p.w_out = (const float*)d_in[9]; p.final_g = (const float*)d_in[10];
    p.out = (float*)d_out; p.ws = (unsigned char*)d_ws;
#if N_LAUNCH_MODE == 1
    for (int ph = 0; ph < N_PHASES; ++ph) {
        p.ph_lo = ph; p.ph_hi = ph + 1;
        hipLaunchKernelGGL(mega, dim3(grid), dim3(512), LDS_BYTES, stream, p);
    }
#else
    p.ph_lo = 0; p.ph_hi = N_PHASES;
    (void)hipMemsetAsync((unsigned char*)d_ws + OFF_BAR, 0, XCD_BAR_WORDS * 4, stream);
    void* args[] = {&p};
    hipError_t e = hipLaunchCooperativeKernel((const void*)mega, dim3(grid), dim3(512), args, LDS_BYTES, stream);
    if (e != hipSuccess) fprintf(stderr, "cooperative launch failed: %s (grid %d)\n", hipGetErrorString(e), grid);
#endif
}
```

```cpp
#include <hip/hip_runtime.h>
#include <hip/hip_cooperative_groups.h>
#include <cstdio>
namespace cg = cooperative_groups;

#ifndef N_LAUNCH_MODE
#define N_LAUNCH_MODE 0
#endif

#define LAS __attribute__((address_space(3)))
typedef unsigned short bf16_t;
typedef short bf16x8 __attribute__((ext_vector_type(8)));
typedef float f32x4 __attribute__((ext_vector_type(4)));
typedef unsigned u32x4 __attribute__((ext_vector_type(4)));
typedef unsigned u32x2 __attribute__((ext_vector_type(2)));

constexpr int LTOK = 4112, MROWS = 32896, MPAD = 33024, NCH = 65, N1 = 8448, INCOLS = 8208;
constexpr int SEG0 = 33;
constexpr float EPS = 1e-6f;
constexpr int LDS_BYTES = 147456;

constexpr size_t SZ_QKV = (size_t)MROWS * 3072 * 2, SZ_ZG = (size_t)MPAD * 2048 * 2, SZ_U = (size_t)MROWS * 1024 * 2;
constexpr size_t SZ_WIN = (size_t)N1 * 1024 * 2, SZ_WOUT = (size_t)1024 * 2048 * 2, SZ_AB = (size_t)MROWS * 16 * 4;
constexpr size_t SZ_HMETA = (size_t)128 * 1024 * 4, SZ_GLAST = 16896, SZ_SSAVE = (size_t)256 * 512 * 8 * 4;
constexpr size_t SZ_HALO = (size_t)8 * 65 * 3 * 3072 * 2, SZ_X = (size_t)MPAD * 1024 * 2;
constexpr size_t OFF_QKV = 0, OFF_ZG = OFF_QKV + SZ_QKV, OFF_U = OFF_ZG + SZ_ZG, OFF_WIN = OFF_U + SZ_U, OFF_WOUT = OFF_WIN + SZ_WIN;
constexpr size_t OFF_AB = OFF_WOUT + SZ_WOUT, OFF_HMETA = OFF_AB + SZ_AB, OFF_GLAST = OFF_HMETA + SZ_HMETA, OFF_SSAVE = OFF_GLAST + SZ_GLAST;
constexpr size_t OFF_HALO = OFF_SSAVE + SZ_SSAVE, OFF_X = OFF_HALO + SZ_HALO, WS_END = OFF_X + SZ_X;
constexpr size_t OFF_BAR = WS_END, WS_END2 = WS_END + 16384;
constexpr size_t OFF_KDT = OFF_X, OFF_PIMG = OFF_X + (size_t)64 * SEG0 * 16384;
static_assert(OFF_PIMG + (size_t)64 * SEG0 * 8192 <= WS_END, "ext images must fit");

struct Params {
    const float *x, *meta, *norm_g, *w_in, *dn_conv_w, *A_log, *dt_bias, *out_g, *sc_conv_w, *w_out, *final_g;
    float* out; unsigned char* ws; int ph_lo, ph_hi;
};

typedef float f32x2 __attribute__((ext_vector_type(2)));
typedef __bf16 bf16x2_n __attribute__((ext_vector_type(2)));
__device__ __forceinline__ unsigned cvt_pk_bf16(float lo, float hi) { f32x2 v = {lo, hi}; bf16x2_n b = __builtin_convertvector(v, bf16x2_n); return __builtin_bit_cast(unsigned, b); }
__device__ __forceinline__ bf16_t f2bf(float f) { unsigned u = __float_as_uint(f); u += 0x7FFFu + ((u >> 16) & 1u); return (bf16_t)(u >> 16); }
__device__ __forceinline__ float bf_lo(unsigned w) { return __uint_as_float(w << 16); }
__device__ __forceinline__ float bf_hi(unsigned w) { return __uint_as_float(w & 0xffff0000u); }
__device__ __forceinline__ float bf2f(bf16_t v) { return __uint_as_float(((unsigned)v) << 16); }
__device__ __forceinline__ float silu_f(float v) { return v * __builtin_amdgcn_rcpf(1.f + __expf(-v)); }
__device__ __forceinline__ float dpp_shr1(float v) { float r; asm volatile("s_nop 1\n\tv_mov_b32_dpp %0, %1 row_shr:1 row_mask:0xf bank_mask:0xf bound_ctrl:1" : "=v"(r) : "v"(v)); return r; }
__device__ __forceinline__ float dpp_shr2(float v) { float r; asm volatile("s_nop 1\n\tv_mov_b32_dpp %0, %1 row_shr:2 row_mask:0xf bank_mask:0xf bound_ctrl:1" : "=v"(r) : "v"(v)); return r; }
__device__ __forceinline__ float dpp_ror1(float v) { float r; asm volatile("s_nop 1\n\tv_mov_b32_dpp %0, %1 row_ror:1 row_mask:0xf bank_mask:0xf bound_ctrl:1" : "=v"(r) : "v"(v)); return r; }
__device__ __forceinline__ float dpp_ror2(float v) { float r; asm volatile("s_nop 1\n\tv_mov_b32_dpp %0, %1 row_ror:2 row_mask:0xf bank_mask:0xf bound_ctrl:1" : "=v"(r) : "v"(v)); return r; }
__device__ __forceinline__ int img128_byte(int row, int elem) { return row * 256 + ((((elem >> 3) ^ (row & 15))) << 4) + (elem & 7) * 2; }
__device__ __forceinline__ int img64_byte(int row, int elem) { return row * 128 + ((((elem >> 3) ^ ((row >> 1) & 7))) << 4) + (elem & 7) * 2; }

namespace pg8 {
constexpr int BM = 256, BK = 64, HALF = 128, HTB = HALF * BK * 2, STAGE_BYTES = 8 * HTB, NXCD = 8, WGM = 8;
__device__ __forceinline__ int lds_byte(int r, int c) { const int st = (r >> 4) * 2 + (c >> 5), rr = r & 15, cc = c & 31, ob = rr * 64 + cc * 2; return st * 1024 + (ob ^ (((ob >> 9) & 1) << 5)); }
__device__ __forceinline__ void stage_rc(int b, int& R, int& C) { const int st = b / 1024, sb = b % 1024, swz = sb ^ (((sb >> 9) & 1) << 5); R = (st >> 1) * 16 + swz / 64; C = (st & 1) * 32 + (swz % 64) / 2; }
struct Unit { int pm, pn, k0, nt; };
struct Gemm { const bf16_t* A; const bf16_t* Bt; int M, N, K; };
template <bool TAIL> struct StaticOrder {
    int nM, nN, nwg, G, c, ntk;
    __device__ __forceinline__ void init(int M, int N, int K, int G_, int c_) { nM = M / BM; nN = N / BM; nwg = nM * nN; G = G_; c = c_; ntk = K / BK; }
    __device__ __forceinline__ bool next(int i, Unit& u) const {
        const long L = (long)i * G + c;
        if (L >= nwg + (TAIL ? 4 * nN : 0)) return false;
        int pm, pn, k0, nt;
        if (TAIL && L >= nwg) { const int idx = (int)(L - nwg); pm = nM; pn = idx % nN; nt = ntk / 4; k0 = (idx / nN) * (ntk / 4) * BK; }
        else {
            int wgid = (int)L; { const int q = nwg / NXCD, r = nwg % NXCD, xcd = wgid % NXCD, off = wgid / NXCD; wgid = (xcd < r ? xcd * (q + 1) : r * (q + 1) + (xcd - r) * q) + off; }
            const int nig = WGM * nN, gid = wgid / nig, fm = gid * WGM, gsz = (nM - fm) < WGM ? (nM - fm) : WGM;
            pm = fm + ((wgid % nig) % gsz); pn = (wgid % nig) / gsz; k0 = 0; nt = ntk;
        }
        u.pm = pm; u.pn = pn; u.k0 = k0; u.nt = nt; return true;
    }
};

template <class Epi, class Sched>
__device__ __forceinline__ void gemm_phase(LAS unsigned char* lds, const Gemm g, const Sched& S, const Epi& E) {
    int tid = threadIdx.x; asm volatile("" : "+v"(tid));
    const int wid = __builtin_amdgcn_readfirstlane(tid >> 6), lane = tid & 63, wr = wid >> 2, wc = wid & 3, fr = lane & 15, fq = lane >> 4;
    const int K = g.K;
    unsigned voffA[2], voffB[2];
#pragma unroll
    for (int i = 0; i < 2; ++i) { int R, C; stage_rc(tid * 16 + i * 8192, R, C); voffA[i] = (unsigned)(R * K + C) * 2u; voffB[i] = (unsigned)(R * K + C) * 2u; }
    const size_t kstep = (size_t)(BK * 2);
    const size_t hstep = (size_t)HALF * K * 2;
    const size_t tstep = 2 * hstep;
    const unsigned ldsw = (unsigned)wid * 1024u;
    const int aoff = lds_byte(wr * 64 + fr, fq * 8), boff = lds_byte(wc * 32 + fr, fq * 8);
#define PG8_SA(b, h) (((b) * 2 + (h)) * HTB)
#define PG8_SB(b, h) ((4 + (b) * 2 + (h)) * HTB)
#define PG8_STAGE(bufoff, gbase, voff) do { _Pragma("unroll") for (int _i = 0; _i < 2; ++_i) \
        __builtin_amdgcn_global_load_lds((const unsigned*)((const char*)(gbase) + (voff)[_i]), (LAS unsigned*)(lds + (bufoff) + ldsw + _i * 8192), 16, 0, 0); } while (0)
#define PG8_LDA(dst, b, h) do { _Pragma("unroll") for (int m = 0; m < 4; ++m) _Pragma("unroll") for (int k = 0; k < 2; ++k) dst[m][k] = *(const LAS bf16x8*)(lds + PG8_SA(b, h) + aoff + m * 2048 + k * 1024); } while (0)
#define PG8_LDB(dst, b, h) do { _Pragma("unroll") for (int n = 0; n < 2; ++n) _Pragma("unroll") for (int k = 0; k < 2; ++k) dst[n][k] = *(const LAS bf16x8*)(lds + PG8_SB(b, h) + boff + n * 2048 + k * 1024); } while (0)
#define PG8_MMA(ai, bj, At, Bt) do { __builtin_amdgcn_s_setprio(1); _Pragma("unroll") for (int m = 0; m < 4; ++m) _Pragma("unroll") for (int n = 0; n < 2; ++n) _Pragma("unroll") for (int k = 0; k < 2; ++k) \
        acc[ai][bj][m][n] = __builtin_amdgcn_mfma_f32_16x16x32_bf16(Bt[n][k], At[m][k], acc[ai][bj][m][n], 0, 0, 0); __builtin_amdgcn_s_setprio(0); } while (0)
#define PG8_WAIT_V(n) asm volatile("s_waitcnt vmcnt(" #n ")" ::: "memory")
#define PG8_WAIT_L(n) asm volatile("s_waitcnt lgkmcnt(" #n ")" ::: "memory")
#define PG8_BAR __builtin_amdgcn_s_barrier()
#define PG8_SCHED __builtin_amdgcn_sched_barrier(0)
    Unit cur, nxt; int ui = 0;
    if (!S.next(0, cur)) return;
    f32x4 acc[2][2][4][2];
#pragma unroll
    for (int a = 0; a < 2; ++a)
#pragma unroll
        for (int b = 0; b < 2; ++b)
#pragma unroll
            for (int m = 0; m < 4; ++m)
#pragma unroll
                for (int n = 0; n < 2; ++n) acc[a][b][m][n] = (f32x4){0.f, 0.f, 0.f, 0.f};
    bf16x8 At[4][2], B0[2][2], B1[2][2];
    const char* cA = (const char*)g.A + (size_t)cur.pm * tstep + (size_t)cur.k0 * 2; const char* cB = (const char*)g.Bt + (size_t)cur.pn * tstep + (size_t)cur.k0 * 2;
    PG8_STAGE(PG8_SB(0, 0), cB, voffB); PG8_STAGE(PG8_SA(0, 0), cA, voffA); PG8_STAGE(PG8_SB(0, 1), cB + hstep, voffB); PG8_STAGE(PG8_SA(0, 1), cA + hstep, voffA);
    if (wr == 1) PG8_BAR;
    PG8_WAIT_V(4); PG8_BAR;
    PG8_STAGE(PG8_SB(1, 0), cB + kstep, voffB); PG8_STAGE(PG8_SA(1, 0), cA + kstep, voffA); PG8_STAGE(PG8_SB(1, 1), cB + hstep + kstep, voffB);
    PG8_WAIT_V(6); PG8_BAR;
    for (;;) {
        const bool has_next = S.next(ui + 1, nxt);
        const char* nA = has_next ? (const char*)g.A + (size_t)nxt.pm * tstep + (size_t)nxt.k0 * 2 : cA; const char* nB = has_next ? (const char*)g.Bt + (size_t)nxt.pn * tstep + (size_t)nxt.k0 * 2 : cB;
        const int nt = cur.nt;
        for (int t = 0; t < nt; t += 2) {
            const bool last = (t == nt - 2);
            const char* a1 = cA + (size_t)(t + 1) * kstep;
            const char* a2 = last ? nA : cA + (size_t)(t + 2) * kstep; const char* b2 = last ? nB : cB + (size_t)(t + 2) * kstep;
            const char* a3 = a2 + kstep; const char* b3 = b2 + kstep;
            PG8_LDB(B0, 0, 0); PG8_SCHED; PG8_LDA(At, 0, 0); PG8_STAGE(PG8_SA(1, 1), a1 + hstep, voffA);
            PG8_WAIT_L(8); PG8_BAR; PG8_WAIT_L(0); PG8_MMA(0, 0, At, B0); PG8_BAR; PG8_SCHED;
            PG8_LDB(B1, 0, 1); PG8_STAGE(PG8_SB(0, 0), b2, voffB);
            PG8_BAR; PG8_WAIT_L(0); PG8_MMA(0, 1, At, B1); PG8_BAR;
            PG8_LDA(At, 0, 1); PG8_STAGE(PG8_SA(0, 0), a2, voffA);
            PG8_BAR; PG8_WAIT_L(0); PG8_MMA(1, 0, At, B0); PG8_BAR; PG8_SCHED;
            PG8_STAGE(PG8_SB(0, 1), b2 + hstep, voffB);
            PG8_WAIT_V(6); PG8_BAR; PG8_MMA(1, 1, At, B1); PG8_BAR;
            PG8_LDB(B0, 1, 0); PG8_SCHED; PG8_LDA(At, 1, 0); PG8_STAGE(PG8_SA(0, 1), a2 + hstep, voffA);
            PG8_WAIT_L(8); PG8_BAR; PG8_WAIT_L(0); PG8_MMA(0, 0, At, B0); PG8_BAR; PG8_SCHED;
            PG8_LDB(B1, 1, 1); PG8_STAGE(PG8_SB(1, 0), b3, voffB);
            PG8_BAR; PG8_WAIT_L(0); PG8_MMA(0, 1, At, B1); PG8_BAR;
            PG8_LDA(At, 1, 1); PG8_STAGE(PG8_SA(1, 0), a3, voffA);
            PG8_BAR; PG8_WAIT_L(0); PG8_MMA(1, 0, At, B0); PG8_BAR; PG8_SCHED;
            PG8_STAGE(PG8_SB(1, 1), b3 + hstep, voffB);
            PG8_WAIT_V(6); PG8_BAR; PG8_MMA(1, 1, At, B1); PG8_BAR;
        }
        E(acc, cur, wr, wc, fr, fq);
        if (!has_next) break;
#pragma unroll
        for (int a = 0; a < 2; ++a)
#pragma unroll
            for (int b = 0; b < 2; ++b)
#pragma unroll
                for (int m = 0; m < 4; ++m)
#pragma unroll
                    for (int n = 0; n < 2; ++n) acc[a][b][m][n] = (f32x4){0.f, 0.f, 0.f, 0.f};
        cur = nxt; cA = nA; cB = nB; ++ui;
    }
    PG8_WAIT_V(0);
    if (wr == 0) PG8_BAR;
    PG8_BAR;
#undef PG8_SA
#undef PG8_SB
#undef PG8_STAGE
#undef PG8_LDA
#undef PG8_LDB
#undef PG8_MMA
#undef PG8_WAIT_V
#undef PG8_WAIT_L
#undef PG8_BAR
#undef PG8_SCHED
}
}

struct Epi1 {
    bf16_t* QKV; bf16_t* ZG; bf16_t* U; float* AB; bf16_t* HALO; const float* A_log; const float* dt_bias; const float* scw;
    __device__ __forceinline__ void operator()(const f32x4 (&acc)[2][2][4][2], const pg8::Unit& u, int wr, int wc, int fr, int fq) const {
        const int row0 = u.pm * 256 + wr * 64 + fr;
        if (u.pn < 12) {
#pragma unroll
            for (int ai = 0; ai < 2; ++ai)
#pragma unroll
                for (int m = 0; m < 4; ++m) {
                    const int r = row0 + ai * 128 + m * 16;
                    if (r < MROWS) {
                        const int b = r / LTOK, t = r - b * LTOK, tm = t & 63, cn = (t >> 6) + 1;
                        const bool halo = (tm >= 13) && (tm <= 15) && (cn <= 64);
                        bf16_t* rp = QKV + (size_t)r * 3072 + u.pn * 256 + wc * 32 + fq * 8;
                        bf16_t* hp = HALO + ((size_t)((b * 65 + cn) * 3 + (tm - 13))) * 3072 + u.pn * 256 + wc * 32 + fq * 8;
#pragma unroll
                        for (int bj = 0; bj < 2; ++bj) {
                            const f32x4 v0 = acc[ai][bj][m][0], v1 = acc[ai][bj][m][1];
                            u32x4 pk; pk[0] = cvt_pk_bf16(v0[0], v0[1]); pk[1] = cvt_pk_bf16(v0[2], v0[3]); pk[2] = cvt_pk_bf16(v1[0], v1[1]); pk[3] = cvt_pk_bf16(v1[2], v1[3]);
                            __builtin_nontemporal_store(pk, (u32x4*)(rp + bj * 128));
                            if (halo) *(u32x4*)(hp + bj * 128) = pk;
                        }
                    }
                }
        } else if (u.pn < 16) {
#pragma unroll
            for (int ai = 0; ai < 2; ++ai)
#pragma unroll
                for (int m = 0; m < 4; ++m) {
                    const int r = row0 + ai * 128 + m * 16;
                    if (r < MROWS) {
                        bf16_t* rp = ZG + (size_t)r * 2048 + (u.pn - 12) * 256 + wc * 32 + fq * 8;
#pragma unroll
                        for (int bj = 0; bj < 2; ++bj) {
                            const f32x4 v0 = acc[ai][bj][m][0], v1 = acc[ai][bj][m][1];
                            u32x4 pk; pk[0] = cvt_pk_bf16(v0[0], v0[1]); pk[1] = cvt_pk_bf16(v0[2], v0[3]); pk[2] = cvt_pk_bf16(v1[0], v1[1]); pk[3] = cvt_pk_bf16(v1[2], v1[3]);
                            __builtin_nontemporal_store(pk, (u32x4*)(rp + bj * 128));
                        }
                    }
                }
        } else if (u.pn < 32) {
            const int ch = (u.pn - 16) * 64 + wc * 16 + fq * 4;
            const f32x4 cw0 = *(const f32x4*)(scw + ch), cw1 = *(const f32x4*)(scw + 1024 + ch), cw2 = *(const f32x4*)(scw + 2048 + ch);
            bf16_t* UH = U; bf16_t* GH = U + (size_t)2 * 1024 * 1024;
#pragma unroll
            for (int ai = 0; ai < 2; ++ai) {
                f32x4 uprev = (f32x4){0.f, 0.f, 0.f, 0.f};
#pragma unroll
                for (int m = 0; m < 4; ++m) {
                    const int r = row0 + ai * 128 + m * 16;
                    const f32x4 vb = acc[ai][0][m][0], vc = acc[ai][0][m][1], vh = acc[ai][1][m][0], vz = acc[ai][1][m][1];
                    f32x4 uu, gg, yy;
#pragma unroll
                    for (int e = 0; e < 4; ++e) { uu[e] = vc[e] * vh[e]; gg[e] = vb[e] * silu_f(vz[e]); }
                    const int b = r / LTOK, t = r - b * LTOK;
#pragma unroll
                    for (int e = 0; e < 4; ++e) {
                        const float s1 = dpp_shr1(uu[e]), s2 = dpp_shr2(uu[e]), r1 = dpp_ror1(uprev[e]), r2 = dpp_ror2(uprev[e]);
                        float p1 = fr >= 1 ? s1 : r1, p2 = fr >= 2 ? s2 : r2;
                        if (t < 1) p1 = 0.f;
                        if (t < 2) p2 = 0.f;
                        yy[e] = gg[e] * (cw0[e] * p2 + cw1[e] * p1 + cw2[e] * uu[e]);
                    }
                    if (r < MROWS) {
                        u32x2 py; py[0] = cvt_pk_bf16(yy[0], yy[1]); py[1] = cvt_pk_bf16(yy[2], yy[3]);
                        __builtin_nontemporal_store(py, (u32x2*)(ZG + (size_t)r * 2048 + 1024 + ch));
                        if (m == 3 && fr >= 14) { u32x2 pu; pu[0] = cvt_pk_bf16(uu[0], uu[1]); pu[1] = cvt_pk_bf16(uu[2], uu[3]); *(u32x2*)(UH + ((size_t)(r >> 6) * 2 + (fr - 14)) * 1024 + ch) = pu; }
                        if (m == 0 && fr <= 1) { u32x2 pg; pg[0] = cvt_pk_bf16(gg[0], gg[1]); pg[1] = cvt_pk_bf16(gg[2], gg[3]); *(u32x2*)(GH + ((size_t)(r >> 6) * 2 + fr) * 1024 + ch) = pg; }
                    }
                    uprev = uu;
                }
            }
        } else {
            if (wc == 0) {
#pragma unroll
                for (int ai = 0; ai < 2; ++ai)
#pragma unroll
                    for (int m = 0; m < 4; ++m) {
                        const int r = row0 + ai * 128 + m * 16;
                        if (r < MROWS) {
                            const f32x4 v = acc[ai][0][m][0];
                            f32x4 o;
#pragma unroll
                            for (int e = 0; e < 4; ++e) {
                                if (fq < 2) { const int hd = 4 * fq + e; const float xx = v[e] + dt_bias[hd]; const float sp = xx > 20.f ? xx : log1pf(__expf(xx)); o[e] = -__expf(A_log[hd]) * sp; }
                                else o[e] = 1.f / (1.f + __expf(-v[e]));
                            }
                            *(f32x4*)(AB + (size_t)r * 16 + 4 * fq) = o;
                        }
                    }
            }
        }
    }
};

struct Epi2 {
    const float* src_real; const float* src_meta; int meta_bstride; float* dst_real; float* dst_meta;
    __device__ __forceinline__ void operator()(const f32x4 (&acc)[2][2][4][2], const pg8::Unit& u, int wr, int wc, int fr, int fq) const {
        const int row0 = u.pm * 256 + wr * 64 + fr, col0 = u.pn * 256 + wc * 32 + 4 * fq;
        if (u.k0 != 0 || u.nt != 32) {
#pragma unroll
            for (int ai = 0; ai < 2; ++ai)
#pragma unroll
                for (int m = 0; m < 4; ++m) {
                    const int r = row0 + ai * 128 + m * 16;
                    if (r < MROWS) {
                        const int b = r / LTOK, t = r - b * LTOK;
                        float* d = (t < 16) ? dst_meta + (size_t)(b * 16 + t) * 1024 : dst_real + ((size_t)b * 4096 + (t - 16)) * 1024;
#pragma unroll
                        for (int bj = 0; bj < 2; ++bj)
#pragma unroll
                            for (int n = 0; n < 2; ++n)
#pragma unroll
                                for (int e = 0; e < 4; ++e) (void)__builtin_amdgcn_global_atomic_fadd_f32((__attribute__((address_space(1))) float*)(d + col0 + bj * 128 + n * 16 + e), acc[ai][bj][m][n][e]);
                    }
                }
            return;
        }
#pragma unroll
        for (int ai = 0; ai < 2; ++ai) {
            f32x4 res[4][2][2]; float* dp[4];
#pragma unroll
            for (int m = 0; m < 4; ++m) {
                int r = row0 + ai * 128 + m * 16; if (r >= MROWS) r = MROWS - 1;
                const int b = r / LTOK, t = r - b * LTOK;
                const float* s;
                if (t < 16) { s = src_meta + (size_t)(b * meta_bstride + t) * 1024; dp[m] = dst_meta + (size_t)(b * 16 + t) * 1024; }
                else { s = src_real + ((size_t)b * 4096 + (t - 16)) * 1024; dp[m] = dst_real + ((size_t)b * 4096 + (t - 16)) * 1024; }
#pragma unroll
                for (int bj = 0; bj < 2; ++bj)
#pragma unroll
                    for (int n = 0; n < 2; ++n) res[m][bj][n] = *(const f32x4*)(s + col0 + bj * 128 + n * 16);
            }
            __builtin_amdgcn_sched_barrier(0);
#pragma unroll
            for (int m = 0; m < 4; ++m) {
                const int r = row0 + ai * 128 + m * 16;
                if (r < MROWS) {
#pragma unroll
                    for (int bj = 0; bj < 2; ++bj)
#pragma unroll
                        for (int n = 0; n < 2; ++n) *(f32x4*)(dp[m] + col0 + bj * 128 + n * 16) = res[m][bj][n] + acc[ai][bj][m][n];
                }
            }
            __builtin_amdgcn_sched_barrier(0);
        }
    }
};

__device__ __forceinline__ int slot_to_col(int s) {
    if (s < 4096) { const int n = (s >> 4) & 1, fq = (s >> 2) & 3, e = s & 3; return (s & ~31) + 8 * fq + 4 * n + e; }
    if (s < 8192) { const int tl = (s - 4096) >> 8, ci = s & 255, bj = ci >> 7, wc = (ci >> 5) & 3, n = (ci >> 4) & 1, fq = (ci >> 2) & 3, e = ci & 3;
        return 4112 + (bj * 2 + n) * 1024 + tl * 64 + wc * 16 + fq * 4 + e; }
    s -= 8192; return s < 16 ? 4096 + s : -1;
}

__device__ __forceinline__ void phase_prep(const Params& p, int l) {
    int tid = threadIdx.x; asm volatile("" : "+v"(tid));
    const int wid = tid >> 6, lane = tid & 63;
    const int gw = blockIdx.x * 8 + wid, nw = gridDim.x * 8;
    bf16_t* WINT = (bf16_t*)(p.ws + OFF_WIN); bf16_t* WOUTT = (bf16_t*)(p.ws + OFF_WOUT); bf16_t* HN = (bf16_t*)(p.ws + OFF_X);
    for (int wt = gw; wt < 2112 + 512; wt += nw) {
        float v[64];
        bf16_t* dst;
        if (wt < 2112) {
            const int sb = wt >> 4, kb = wt & 15, slot = sb * 64 + lane, oc = slot_to_col(slot);
            const float* src = p.w_in + (size_t)l * 1024 * INCOLS + (size_t)(kb * 64) * INCOLS + (oc < 0 ? 0 : oc);
#pragma unroll
            for (int kk = 0; kk < 64; ++kk) v[kk] = src[(size_t)kk * INCOLS];
            if (oc < 0) {
#pragma unroll
                for (int kk = 0; kk < 64; ++kk) v[kk] = 0.f;
            }
            dst = WINT + (size_t)slot * 1024 + kb * 64;
        } else {
            const int w2 = wt - 2112, nb = w2 >> 5, kb = w2 & 31, n = nb * 64 + lane;
            const float* src = p.w_out + (size_t)l * 2048 * 1024 + (size_t)(kb * 64) * 1024 + n;
#pragma unroll
            for (int kk = 0; kk < 64; ++kk) v[kk] = src[(size_t)kk * 1024];
            dst = WOUTT + (size_t)n * 2048 + kb * 64;
        }
#pragma unroll
        for (int q = 0; q < 8; ++q) {
            u32x4 o; o[0] = cvt_pk_bf16(v[8 * q], v[8 * q + 1]); o[1] = cvt_pk_bf16(v[8 * q + 2], v[8 * q + 3]); o[2] = cvt_pk_bf16(v[8 * q + 4], v[8 * q + 5]); o[3] = cvt_pk_bf16(v[8 * q + 6], v[8 * q + 7]);
            *(u32x4*)(dst + 8 * q) = o;
        }
    }
    if (l == 0) {
        const int gi = blockIdx.x * 512 + tid;
        if (gi < 32768) *(f32x4*)(p.out + (size_t)32640 * 1024 + (size_t)gi * 4) = *(const f32x4*)(p.x + (size_t)32640 * 1024 + (size_t)gi * 4);
    }
    const float* gain = p.norm_g + (size_t)l * 1024;
    const float* HM = (const float*)(p.ws + OFF_HMETA);
    f32x4 gq[4];
#pragma unroll
    for (int q = 0; q < 4; ++q) gq[q] = *(const f32x4*)(gain + lane * 4 + 256 * q);
    for (int rb = gw * 4; rb < MROWS; rb += nw * 4) {
        f32x4 v[4][4];
#pragma unroll
        for (int k = 0; k < 4; ++k) {
            const int r = rb + k, b = r / LTOK, t = r - b * LTOK;
            const float* s;
            if (t < 16) s = (l == 0) ? p.meta + (size_t)t * 1024 : HM + (size_t)(b * 16 + t) * 1024;
            else s = ((l == 0) ? p.x : (const float*)p.out) + ((size_t)b * 4096 + (t - 16)) * 1024;
#pragma unroll
            for (int q = 0; q < 4; ++q) v[k][q] = *(const f32x4*)(s + lane * 4 + 256 * q);
        }
#pragma unroll
        for (int k = 0; k < 4; ++k) {
            float ss = 0.f;
#pragma unroll
            for (int q = 0; q < 4; ++q) ss += v[k][q][0] * v[k][q][0] + v[k][q][1] * v[k][q][1] + v[k][q][2] * v[k][q][2] + v[k][q][3] * v[k][q][3];
#pragma unroll
            for (int o = 32; o >= 1; o >>= 1) ss += __shfl_xor(ss, o);
            const float rstd = rsqrtf(ss * (1.f / 1024.f) + EPS);
#pragma unroll
            for (int q = 0; q < 4; ++q) {
                u32x2 o; o[0] = cvt_pk_bf16(v[k][q][0] * rstd * gq[q][0], v[k][q][1] * rstd * gq[q][1]); o[1] = cvt_pk_bf16(v[k][q][2] * rstd * gq[q][2], v[k][q][3] * rstd * gq[q][3]);
                *(u32x2*)(HN + (size_t)(rb + k) * 1024 + lane * 4 + 256 * q) = o;
            }
        }
    }
}

__device__ __forceinline__ void stage_a(const Params& p, int l, int seg, LAS unsigned char* lds, const bool dry = false) {
    bf16_t* QKV = (bf16_t*)(p.ws + OFF_QKV); const bf16_t* HALO = (const bf16_t*)(p.ws + OFF_HALO);
    const float* AB = (const float*)(p.ws + OFF_AB); float* GLAST = (float*)(p.ws + OFF_GLAST);
    LAS float* AM = (LAS float*)(lds); LAS unsigned char* KB = lds + 81920; LAS unsigned char* QB = lds + 98304;
    LAS unsigned char* RT = lds + 16384; LAS unsigned char* OUTS = lds + 49152; LAS unsigned char* XI = lds + 81920;
    LAS bf16_t* KDS = (LAS bf16_t*)(lds + 114688); LAS unsigned char* PS = lds + 132096; LAS float* GS = (LAS float*)(lds + 140288); LAS float* BS = (LAS float*)(lds + 140544);
    const int nchunks = seg == 0 ? SEG0 : NCH - SEG0, c_lo = seg == 0 ? 0 : SEG0, ntasks = 64 * nchunks;
    LAS float* CW = (LAS float*)(lds + 140800);
    int h_loaded = -1;
    for (int task = blockIdx.x; task < ntasks; task += gridDim.x) {
        int tid = threadIdx.x; asm volatile("" : "+v"(tid));
        const int wid = __builtin_amdgcn_readfirstlane(tid >> 6), lane = tid & 63, fr = lane & 15, fq = lane >> 4;
        const int bh = task & 63, cs = task >> 6, c = c_lo + cs, b = bh >> 3, h = bh & 7;
        const int t0 = 64 * c - 48;
        const long rowbase = (long)b * LTOK + t0;
        const int gidx = tid & 15, rs = tid >> 4;
        const bool okl = (t0 + lane) >= 0;
        const float* ab = AB + (size_t)(okl ? rowbase + lane : (long)b * LTOK) * 16;
        const float g0 = ab[h], b0 = ab[8 + h];
        u32x4 raw[3][5]; float mk[5];
#pragma unroll
        for (int r5 = 0; r5 < 5; ++r5) {
            const int ii = 2 * rs - 3 + r5;
            const bool okr = (t0 + ii) >= 0;
            mk[r5] = okr ? 1.f : 0.f;
            const bf16_t* src = (ii >= 0) ? QKV + (size_t)(okr ? rowbase + ii : (long)b * LTOK) * 3072 + h * 128 + gidx * 8 : HALO + ((size_t)((b * 65 + c) * 3 + (ii + 3))) * 3072 + h * 128 + gidx * 8;
#pragma unroll
            for (int part = 0; part < 3; ++part) raw[part][r5] = *(const u32x4*)(src + part * 1024);
        }
        if (c == 0) {
#pragma unroll
            for (int r5 = 0; r5 < 5; ++r5)
#pragma unroll
                for (int part = 0; part < 3; ++part) if (mk[r5] == 0.f) raw[part][r5] = (u32x4){0u, 0u, 0u, 0u};
        }
        if (h != h_loaded) {
#pragma unroll
            for (int q = 0; q < 3; ++q) { const int n = tid + 512 * q, part = n >> 9, j = (n >> 7) & 3, cc = n & 127; CW[n] = p.dn_conv_w[((size_t)l * 4 + j) * 3072 + part * 1024 + h * 128 + cc]; }
            h_loaded = h;
            __syncthreads();
        }
        float gsc = okl ? g0 : 0.f, bsc = okl ? b0 : 0.f;
#pragma unroll
        for (int off = 1; off < 64; off <<= 1) { const float v = __shfl_up(gsc, off); if (lane >= off) gsc += v; }
        if (wid == 0) {
            GS[lane] = gsc; BS[lane] = bsc;
            if (lane == 63 && !dry) GLAST[bh * 65 + c] = __expf(gsc);
        }
        float qreg[2][8], rv[2][8], rk[2][8];
        const float glast = __shfl(gsc, 63);
#pragma unroll
        for (int pp = 0; pp < 2; ++pp) {
            const int i = 2 * rs + pp; const bool valid = (t0 + i) >= 0;
            const float Gi = __shfl(gsc, i), bi = __shfl(bsc, i);
            float y[3][8];
#pragma unroll
            for (int part = 0; part < 3; ++part) {
                const int col = part * 1024 + h * 128 + gidx * 8;
                float a[8];
#pragma unroll
                for (int e = 0; e < 8; ++e) a[e] = 0.f;
#pragma unroll
                for (int j = 0; j < 4; ++j) {
                    const u32x4 rw = raw[part][pp + j];
                    const LAS float* cw = CW + (part * 4 + j) * 128 + gidx * 8;
                    const f32x4 w0 = *(const LAS f32x4*)cw, w1 = *(const LAS f32x4*)(cw + 4);
                    a[0] += w0[0] * bf_lo(rw[0]); a[1] += w0[1] * bf_hi(rw[0]); a[2] += w0[2] * bf_lo(rw[1]); a[3] += w0[3] * bf_hi(rw[1]);
                    a[4] += w1[0] * bf_lo(rw[2]); a[5] += w1[1] * bf_hi(rw[2]); a[6] += w1[2] * bf_lo(rw[3]); a[7] += w1[3] * bf_hi(rw[3]);
                }
#pragma unroll
                for (int e = 0; e < 8; ++e) y[part][e] = valid ? silu_f(a[e]) : 0.f;

            }
            float sq = 0.f, sk = 0.f;
#pragma unroll
            for (int e = 0; e < 8; ++e) { sq += y[0][e] * y[0][e]; sk += y[1][e] * y[1][e]; }
#pragma unroll
            for (int o = 1; o < 16; o <<= 1) { sq += __shfl_xor(sq, o); sk += __shfl_xor(sk, o); }
            const float iq = rsqrtf(sq + EPS) * 0.08838834764831845f, ik = rsqrtf(sk + EPS);
            const float eg = __expf(Gi), egl = __expf(glast - Gi);
            float qv[8], kv[8];
#pragma unroll
            for (int e = 0; e < 8; ++e) { qv[e] = y[0][e] * iq; kv[e] = y[1][e] * ik; qreg[pp][e] = qv[e] * eg; }
            u32x4 pk, pq;
            pk[0] = cvt_pk_bf16(kv[0], kv[1]); pk[1] = cvt_pk_bf16(kv[2], kv[3]); pk[2] = cvt_pk_bf16(kv[4], kv[5]); pk[3] = cvt_pk_bf16(kv[6], kv[7]);
            pq[0] = cvt_pk_bf16(qv[0], qv[1]); pq[1] = cvt_pk_bf16(qv[2], qv[3]); pq[2] = cvt_pk_bf16(qv[4], qv[5]); pq[3] = cvt_pk_bf16(qv[6], qv[7]);
            *(LAS u32x4*)(KB + img128_byte(i, gidx * 8)) = pk;
            *(LAS u32x4*)(QB + img128_byte(i, gidx * 8)) = pq;
            const float bk = bi * eg;
#pragma unroll
            for (int e = 0; e < 8; ++e) { rv[pp][e] = bi * y[2][e]; rk[pp][e] = bk * kv[e]; }
            u32x4 pd;
            pd[0] = cvt_pk_bf16(kv[0] * egl, kv[1] * egl); pd[1] = cvt_pk_bf16(kv[2] * egl, kv[3] * egl); pd[2] = cvt_pk_bf16(kv[4] * egl, kv[5] * egl); pd[3] = cvt_pk_bf16(kv[6] * egl, kv[7] * egl);
            *(LAS u32x4*)(KDS + i * 136 + gidx * 8) = pd;
        }
#pragma unroll
        for (int e = 0; e < 8; ++e) {
            const int jv = gidx * 8 + e;
            *(LAS unsigned*)(RT + img64_byte(jv, 2 * rs)) = cvt_pk_bf16(rv[0][e], rv[1][e]);
            *(LAS unsigned*)(RT + img64_byte(128 + jv, 2 * rs)) = cvt_pk_bf16(rk[0][e], rk[1][e]);
        }
        __syncthreads();
#pragma unroll
        for (int pp = 0; pp < 2; ++pp) {
            const int i = 2 * rs + pp;
            if (t0 + i >= 0 && !dry) {
                u32x4 o; o[0] = cvt_pk_bf16(qreg[pp][0], qreg[pp][1]); o[1] = cvt_pk_bf16(qreg[pp][2], qreg[pp][3]); o[2] = cvt_pk_bf16(qreg[pp][4], qreg[pp][5]); o[3] = cvt_pk_bf16(qreg[pp][6], qreg[pp][7]);
                *(u32x4*)(QKV + (size_t)(rowbase + i) * 3072 + h * 128 + ((gidx ^ (i & 15)) << 3)) = o;
            }
        }
        {
#pragma unroll
            for (int k3 = 0; k3 < 3; ++k3) {
                const int idx = wid + 8 * k3;
                if (idx < 20) {
                    const int mat = idx >= 10 ? 1 : 0, k = idx - 10 * mat;
                    const int rt = (k >= 6) ? 3 : (k >= 3) ? 2 : (k >= 1) ? 1 : 0, ct = k - rt * (rt + 1) / 2;
                    LAS unsigned char* Ab = mat == 0 ? KB : QB;
                    f32x4 acc = (f32x4){0.f, 0.f, 0.f, 0.f};
#pragma unroll
                    for (int ks = 0; ks < 4; ++ks) {
                        const bf16x8 af = *(const LAS bf16x8*)(Ab + img128_byte(16 * rt + fr, 32 * ks + 8 * fq));
                        const bf16x8 bf = *(const LAS bf16x8*)(KB + img128_byte(16 * ct + fr, 32 * ks + 8 * fq));
                        acc = __builtin_amdgcn_mfma_f32_16x16x32_bf16(af, bf, acc, 0, 0, 0);
                    }
                    const int j = 16 * ct + fr; const float Gj = GS[j];
#pragma unroll
                    for (int rg = 0; rg < 4; ++rg) {
                        const int i = 16 * rt + 4 * fq + rg;
                        const float dec = __expf(fminf(GS[i] - Gj, 0.f));
                        if (mat == 0) {
                            const float av_ = (i > j) ? BS[i] * acc[rg] * dec : 0.f;
                            AM[i * 64 + j] = av_;
                            if (rt >= 2 && ct < 2) *(LAS bf16_t*)(OUTS + (i - 32) * 64 + j * 2) = f2bf(av_);
                        }
                        else *(LAS bf16_t*)(PS + img64_byte(i, j)) = f2bf((i >= j) ? acc[rg] * dec : 0.f);
                    }
                }
            }
            if (wid < 6) {
                const int rt = (wid < 3) ? 0 : (wid < 5) ? 1 : 2, ct = (wid < 3) ? wid + 1 : (wid < 5) ? wid - 1 : 3;
                const int j = 16 * ct + fr;
#pragma unroll
                for (int rg = 0; rg < 4; ++rg) *(LAS bf16_t*)(PS + img64_byte(16 * rt + 4 * fq + rg, j)) = (bf16_t)0;
            }
        }
        __syncthreads();
        if (wid == 0) {
            __builtin_amdgcn_s_setprio(3);
            const int hi = lane >> 5, cl = lane & 31;
            const LAS float* Ab = AM + hi * (32 * 64 + 32);
            LAS unsigned char* A21I = OUTS; LAS unsigned char* XT11 = OUTS + 2048; LAS unsigned char* YT = OUTS + 4096;
            f32x2 xp[16];
            f32x4 abuf[2][8];
            abuf[1][0] = *(const LAS f32x4*)(Ab + 64);
#pragma unroll
            for (int i = 0; i < 32; ++i) {
                if (i + 1 < 32 && i + 1 >= 2) {
#pragma unroll
                    for (int g = 0; g < (i + 1 + 3) / 4; ++g) abuf[(i + 1) & 1][g] = *(const LAS f32x4*)(Ab + (i + 1) * 64 + g * 4);
                }
                __builtin_amdgcn_sched_barrier(0);
                f32x2 a0 = (f32x2){0.f, 0.f}, a1 = (f32x2){0.f, 0.f}; float tl = 0.f;
#pragma unroll
                for (int g = 0; g < (i + 3) / 4; ++g) {
                    const f32x4 av = abuf[i & 1][g];
                    if (4 * g + 1 < i) a0 += (f32x2){av[0], av[1]} * xp[2 * g];
                    else if (4 * g < i) tl += av[0] * xp[2 * g][0];
                    if (4 * g + 3 < i) a1 += (f32x2){av[2], av[3]} * xp[2 * g + 1];
                    else if (4 * g + 2 < i) tl += av[2] * xp[2 * g + 1][0];
                }
                float xi = ((i == cl) ? 1.f : 0.f) - (((a0[0] + a0[1]) + (a1[0] + a1[1])) + tl);
                asm volatile("" : "+v"(xi));
                if (i & 1) xp[i >> 1][1] = xi; else { xp[i >> 1][0] = xi; xp[i >> 1][1] = 0.f; }
                __builtin_amdgcn_sched_barrier(0);
            }
#pragma unroll
            for (int i = 0; i < 32; ++i) {
                int lo = lane; asm volatile("" : "+v"(lo));
                *(LAS bf16_t*)(XI + img64_byte(32 * (lo >> 5) + i, lo)) = f2bf(xp[i >> 1][i & 1]);
                if (lo >> 5) *(LAS bf16_t*)(XI + img64_byte(i, lo)) = (bf16_t)0;
            }
            if (!hi) {
#pragma unroll
                for (int q = 0; q < 16; ++q) *(LAS unsigned*)(XT11 + cl * 64 + q * 4) = cvt_pk_bf16(xp[q][0], xp[q][1]);
            }
#pragma unroll
            for (int rtp = 0; rtp < 2; ++rtp)
#pragma unroll
                for (int ctp = 0; ctp < 2; ++ctp) {
                    const bf16x8 afr = *(const LAS bf16x8*)(A21I + (16 * rtp + fr) * 64 + fq * 16);
                    const bf16x8 bfr2 = *(const LAS bf16x8*)(XT11 + (16 * ctp + fr) * 64 + fq * 16);
                    const f32x4 yv = __builtin_amdgcn_mfma_f32_16x16x32_bf16(afr, bfr2, (f32x4){0.f, 0.f, 0.f, 0.f}, 0, 0, 0);
                    u32x2 o; o[0] = cvt_pk_bf16(yv[0], yv[1]); o[1] = cvt_pk_bf16(yv[2], yv[3]);
                    *(LAS u32x2*)(YT + (16 * ctp + fr) * 64 + (16 * rtp + 4 * fq) * 2) = o;
                }
#pragma unroll
            for (int rtp = 0; rtp < 2; ++rtp)
#pragma unroll
                for (int ctp = 0; ctp < 2; ++ctp) {
                    const bf16x8 afr = *(const LAS bf16x8*)(XI + img64_byte(32 + 16 * rtp + fr, 32 + 8 * fq));
                    const bf16x8 bfr2 = *(const LAS bf16x8*)(YT + (16 * ctp + fr) * 64 + fq * 16);
                    const f32x4 xv = __builtin_amdgcn_mfma_f32_16x16x32_bf16(afr, bfr2, (f32x4){0.f, 0.f, 0.f, 0.f}, 0, 0, 0);
#pragma unroll
                    for (int rg = 0; rg < 4; ++rg) *(LAS bf16_t*)(XI + img64_byte(32 + 16 * rtp + 4 * fq + rg, 16 * ctp + fr)) = f2bf(-xv[rg]);
                }
            __builtin_amdgcn_s_setprio(0);
        } else {
            unsigned char* kdt = p.ws + OFF_KDT + (size_t)(bh * SEG0 + cs) * 16384;
#pragma unroll
            for (int pp = 0; pp < 3; ++pp) {
                const int id = (tid - 64) + 448 * pp;
                if (id < 1024) {
                    const int dk = id & 127, ic = id >> 7;
                    unsigned short e[8];
#pragma unroll
                    for (int q = 0; q < 8; ++q) e[q] = KDS[(8 * ic + q) * 136 + dk];
                    u32x4 o; o[0] = e[0] | ((unsigned)e[1] << 16); o[1] = e[2] | ((unsigned)e[3] << 16); o[2] = e[4] | ((unsigned)e[5] << 16); o[3] = e[6] | ((unsigned)e[7] << 16);
                    if (!dry) *(u32x4*)(kdt + dk * 128 + ((ic ^ ((dk >> 1) & 7)) << 4)) = o;
                }
            }
            if (tid >= 256) {
                unsigned char* pim = p.ws + OFF_PIMG + (size_t)(bh * SEG0 + cs) * 8192;
#pragma unroll
                for (int pp = 0; pp < 2; ++pp) { const int id = (tid - 256) + 256 * pp; if (!dry) *(u32x4*)(pim + id * 16) = *(const LAS u32x4*)(PS + id * 16); }
            }
        }
        __syncthreads();
        {
            bf16x8 af[4][2], bfr[2][2];
#pragma unroll
            for (int rt = 0; rt < 4; ++rt)
#pragma unroll
                for (int ks = 0; ks < 2; ++ks) af[rt][ks] = *(const LAS bf16x8*)(XI + img64_byte(16 * rt + fr, 32 * ks + 8 * fq));
#pragma unroll
            for (int jj = 0; jj < 2; ++jj)
#pragma unroll
                for (int ks = 0; ks < 2; ++ks) bfr[jj][ks] = *(const LAS bf16x8*)(RT + img64_byte(16 * (2 * wid + jj) + fr, 32 * ks + 8 * fq));
#pragma unroll
            for (int rt = 0; rt < 4; ++rt)
#pragma unroll
                for (int jj = 0; jj < 2; ++jj) {
                    f32x4 acc = (f32x4){0.f, 0.f, 0.f, 0.f};
#pragma unroll
                    for (int ks = 0; ks < 2; ++ks) acc = __builtin_amdgcn_mfma_f32_16x16x32_bf16(af[rt][ks], bfr[jj][ks], acc, 0, 0, 0);
                    const int jc = 16 * (2 * wid + jj) + fr;
#pragma unroll
                    for (int rg = 0; rg < 4; ++rg) *(LAS bf16_t*)(OUTS + (16 * rt + 4 * fq + rg) * 512 + jc * 2) = f2bf(acc[rg]);
                }
        }
        __syncthreads();
        {
            const int i_lo = dry ? 64 : (t0 < 0 ? -t0 : 0);
#pragma unroll
            for (int q = 0; q < 4; ++q) {
                const int id = tid + 512 * q, half = id >> 10, rem = id & 1023, i = rem >> 4, ch = rem & 15;
                const u32x4 o = *(const LAS u32x4*)(OUTS + i * 512 + half * 256 + ch * 16);
                if (i >= i_lo) *(u32x4*)(QKV + (size_t)(rowbase + i) * 3072 + (half ? 1024 : 2048) + h * 128 + ((half ? (ch ^ (i & 15)) : ch) << 3)) = o;
            }
        }
        __syncthreads();
    }
}

struct BRegs { bf16x8 ay[4], ap[2], ak[2]; unsigned u[2][4]; float gl; };
__device__ __forceinline__ void stage_b(const Params& p, int seg, LAS unsigned char* lds, const bool dry = false) {
    int tid = threadIdx.x; asm volatile("" : "+v"(tid));
    const int wid = __builtin_amdgcn_readfirstlane(tid >> 6), lane = tid & 63, fr = lane & 15, fq = lane >> 4;
    bf16_t* QKV = (bf16_t*)(p.ws + OFF_QKV); const float* GLAST = (const float*)(p.ws + OFF_GLAST); float* SSAVE = (float*)(p.ws + OFF_SSAVE);
    LAS unsigned char* STL = lds; LAS unsigned char* VNTL = lds + 8192;
    const int nch = seg == 0 ? SEG0 : NCH - SEG0, c_lo = seg == 0 ? 0 : SEG0;
    const bf16x8 zero8 = (bf16x8){0, 0, 0, 0, 0, 0, 0, 0};
    for (int wk = blockIdx.x; wk < 256; wk += gridDim.x) {
        const int bh = (wk & 7) + 8 * (wk >> 5), sl = (wk >> 3) & 3, b = bh >> 3, h = bh & 7;
        f32x4 accS[2];
        if (seg == 0) { accS[0] = (f32x4){0.f, 0.f, 0.f, 0.f}; accS[1] = accS[0]; }
        else { accS[0] = *(const f32x4*)(SSAVE + ((size_t)wk * 512 + tid) * 8); accS[1] = *(const f32x4*)(SSAVE + ((size_t)wk * 512 + tid) * 8 + 4); }
#pragma unroll
        for (int ct = 0; ct < 2; ++ct) { u32x2 o; o[0] = cvt_pk_bf16(accS[ct][0], accS[ct][1]); o[1] = cvt_pk_bf16(accS[ct][2], accS[ct][3]); *(LAS u32x2*)(STL + img128_byte(16 * ct + fr, 16 * wid + 4 * fq)) = o; }
        const int yrow = 16 * (wid & 3) + fr;
        auto issue_y = [&](int cs_, BRegs& R) {
            {
                const int cs = cs_ < nch ? cs_ : nch - 1;
                const int c = c_lo + cs, t0 = 64 * c - 48;
                const long rowbase = (long)b * LTOK + t0;
                const bool valid = t0 + yrow >= 0;
                const bf16_t* rp = QKV + (size_t)(valid ? rowbase + yrow : (long)b * LTOK) * 3072 + (wid < 4 ? 1024 : 0) + h * 128;
#pragma unroll
                for (int ks = 0; ks < 4; ++ks) R.ay[ks] = *(const bf16x8*)(rp + (((4 * ks + fq) ^ (yrow & 15)) << 3));
                if (wid < 4) {
#pragma unroll
                    for (int ct = 0; ct < 2; ++ct)
#pragma unroll
                        for (int rg = 0; rg < 4; ++rg) {
                            const int i = 16 * wid + 4 * fq + rg;
                            const bool okr = (t0 + i) >= 0;
                            R.u[ct][rg] = QKV[(size_t)(okr ? rowbase + i : (long)b * LTOK) * 3072 + 2048 + h * 128 + sl * 32 + 16 * ct + fr];
                        }
                }
                R.gl = GLAST[bh * 65 + c];
            }
        };
        auto issue_rest = [&](int cs_, BRegs& R) {
            {
                const int cs = cs_ < nch ? cs_ : nch - 1;
                const unsigned char* kdt = p.ws + OFF_KDT + (size_t)(bh * SEG0 + cs) * 16384;
                const unsigned char* pim = p.ws + OFF_PIMG + (size_t)(bh * SEG0 + cs) * 8192;
                const int dk = 16 * wid + fr;
#pragma unroll
                for (int ks = 0; ks < 2; ++ks) R.ak[ks] = *(const bf16x8*)(kdt + dk * 128 + (((4 * ks + fq) ^ ((dk >> 1) & 7)) << 4));
                if (wid >= 4) {
                    const int pi = 16 * (wid - 4) + fr;
#pragma unroll
                    for (int ks = 0; ks < 2; ++ks) R.ap[ks] = *(const bf16x8*)(pim + pi * 128 + (((4 * ks + fq) ^ ((pi >> 1) & 7)) << 4));
                }
            }
        };
        auto body = [&](int cs, BRegs& R) {
            const int c = c_lo + cs, t0 = 64 * c - 48;
            const long rowbase = (long)b * LTOK + t0;
            float uu[2][4];
#pragma unroll
            for (int ct = 0; ct < 2; ++ct)
#pragma unroll
                for (int rg = 0; rg < 4; ++rg) uu[ct][rg] = (t0 + 16 * wid + 4 * fq + rg >= 0) ? __uint_as_float(R.u[ct][rg] << 16) : 0.f;
            const bool yvalid = t0 + yrow >= 0;
            const float gl = R.gl;
            asm volatile("s_waitcnt lgkmcnt(0)" ::: "memory"); __builtin_amdgcn_s_barrier(); asm volatile("" ::: "memory");
            f32x4 accY[2]; accY[0] = (f32x4){0.f, 0.f, 0.f, 0.f}; accY[1] = accY[0];
            bf16x8 bfy[4][2];
#pragma unroll
            for (int ks = 0; ks < 4; ++ks)
#pragma unroll
                for (int ct = 0; ct < 2; ++ct) bfy[ks][ct] = *(const LAS bf16x8*)(STL + img128_byte(16 * ct + fr, 32 * ks + 8 * fq));
#pragma unroll
            for (int ks = 0; ks < 4; ++ks) {
#pragma unroll
                for (int ct = 0; ct < 2; ++ct) accY[ct] = __builtin_amdgcn_mfma_f32_16x16x32_bf16(yvalid ? R.ay[ks] : zero8, bfy[ks][ct], accY[ct], 0, 0, 0);
            }
            if (wid < 4) {
#pragma unroll
                for (int ct = 0; ct < 2; ++ct) {
                    u32x2 o; o[0] = cvt_pk_bf16(uu[ct][0] - accY[ct][0], uu[ct][1] - accY[ct][1]); o[1] = cvt_pk_bf16(uu[ct][2] - accY[ct][2], uu[ct][3] - accY[ct][3]);
                    *(LAS u32x2*)(VNTL + img64_byte(16 * ct + fr, 16 * wid + 4 * fq)) = o;
                }
            }
            issue_y(cs + 2, R);
            asm volatile("s_waitcnt lgkmcnt(0)" ::: "memory"); __builtin_amdgcn_s_barrier(); asm volatile("" ::: "memory");
            bf16x8 bfv[2][2];
#pragma unroll
            for (int ks = 0; ks < 2; ++ks)
#pragma unroll
                for (int ct = 0; ct < 2; ++ct) bfv[ks][ct] = *(const LAS bf16x8*)(VNTL + img64_byte(16 * ct + fr, 32 * ks + 8 * fq));
            if (wid >= 4) {
                const int rt = wid - 4;
#pragma unroll
                for (int ks = 0; ks < 2; ++ks) {
#pragma unroll
                    for (int ct = 0; ct < 2; ++ct) accY[ct] = __builtin_amdgcn_mfma_f32_16x16x32_bf16(R.ap[ks], bfv[ks][ct], accY[ct], 0, 0, 0);
                }
#pragma unroll
                for (int ct = 0; ct < 2; ++ct)
#pragma unroll
                    for (int rg = 0; rg < 4; ++rg) {
                        const int i = 16 * rt + 4 * fq + rg;
                        if (t0 + i >= 0 && !dry) QKV[(size_t)(rowbase + i) * 3072 + 2048 + h * 128 + sl * 32 + 16 * ct + fr] = f2bf(accY[ct][rg]);
                    }
            }
            accS[0] *= gl; accS[1] *= gl;
#pragma unroll
            for (int ks = 0; ks < 2; ++ks) {
#pragma unroll
                for (int ct = 0; ct < 2; ++ct) accS[ct] = __builtin_amdgcn_mfma_f32_16x16x32_bf16(R.ak[ks], bfv[ks][ct], accS[ct], 0, 0, 0);
            }
#pragma unroll
            for (int ct = 0; ct < 2; ++ct) { u32x2 o; o[0] = cvt_pk_bf16(accS[ct][0], accS[ct][1]); o[1] = cvt_pk_bf16(accS[ct][2], accS[ct][3]); *(LAS u32x2*)(STL + img128_byte(16 * ct + fr, 16 * wid + 4 * fq)) = o; }
            issue_rest(cs + 2, R);
        };
        BRegs R0, R1;
        issue_y(0, R0); issue_rest(0, R0); issue_y(1, R1); issue_rest(1, R1);
        for (int cs = 0; cs < nch; cs += 2) {
            body(cs, R0);
            if (cs + 1 < nch) body(cs + 1, R1);
        }
        __syncthreads();
        if (seg == 0 && !dry) { *(f32x4*)(SSAVE + ((size_t)wk * 512 + tid) * 8) = accS[0]; *(f32x4*)(SSAVE + ((size_t)wk * 512 + tid) * 8 + 4) = accS[1]; }
    }
}

__device__ __forceinline__ void phase_mix(const Params& p, int l, const bool dry = false) {
    int tid = threadIdx.x; asm volatile("" : "+v"(tid));
    const int wid = tid >> 6, lane = tid & 63;
    const int gw = blockIdx.x * 8 + wid, nw = gridDim.x * 8;
    const bf16_t* QKV = (const bf16_t*)(p.ws + OFF_QKV); bf16_t* ZG = (bf16_t*)(p.ws + OFF_ZG); const bf16_t* U = (const bf16_t*)(p.ws + OFF_U);
    const float* og = p.out_g + (size_t)l * 128 + (lane & 7) * 16;
    const float* cw = p.sc_conv_w + (size_t)l * 3 * 1024 + lane * 16;
    float ogr[16];
#pragma unroll
    for (int e = 0; e < 16; ++e) ogr[e] = og[e];
    for (int rb = gw * 4; rb < MROWS; rb += nw * 4) {
        u32x4 ov[4][2], zv[4][2];
#pragma unroll
        for (int k = 0; k < 4; ++k) {
            const size_t r = (size_t)(rb + k);
            ov[k][0] = *(const u32x4*)(QKV + r * 3072 + 2048 + lane * 16); ov[k][1] = *(const u32x4*)(QKV + r * 3072 + 2048 + lane * 16 + 8);
            zv[k][0] = *(const u32x4*)(ZG + r * 2048 + lane * 16); zv[k][1] = *(const u32x4*)(ZG + r * 2048 + lane * 16 + 8);
        }
#pragma unroll
        for (int k = 0; k < 4; ++k) {
            const size_t r = (size_t)(rb + k);
            float o[16], z[16];
#pragma unroll
            for (int q = 0; q < 4; ++q) { o[2 * q] = bf_lo(ov[k][0][q]); o[2 * q + 1] = bf_hi(ov[k][0][q]); o[8 + 2 * q] = bf_lo(ov[k][1][q]); o[8 + 2 * q + 1] = bf_hi(ov[k][1][q]);
                z[2 * q] = bf_lo(zv[k][0][q]); z[2 * q + 1] = bf_hi(zv[k][0][q]); z[8 + 2 * q] = bf_lo(zv[k][1][q]); z[8 + 2 * q + 1] = bf_hi(zv[k][1][q]); }
            float ss = 0.f;
#pragma unroll
            for (int e = 0; e < 16; ++e) ss += o[e] * o[e];
            ss += __shfl_xor(ss, 1); ss += __shfl_xor(ss, 2); ss += __shfl_xor(ss, 4);
            const float rstd = rsqrtf(ss * (1.f / 128.f) + EPS);
            float y[16];
#pragma unroll
            for (int e = 0; e < 16; ++e) y[e] = o[e] * rstd * ogr[e] * silu_f(z[e]);
            u32x4 w0, w1;
#pragma unroll
            for (int q = 0; q < 4; ++q) { w0[q] = cvt_pk_bf16(y[2 * q], y[2 * q + 1]); w1[q] = cvt_pk_bf16(y[8 + 2 * q], y[8 + 2 * q + 1]); }
            if (!dry) { *(u32x4*)(ZG + r * 2048 + lane * 16) = w0; *(u32x4*)(ZG + r * 2048 + lane * 16 + 8) = w1; }
        }
    }
    const bf16_t* UH = U; const bf16_t* GH = U + (size_t)2 * 1024 * 1024;
    for (int it = gw; it < 2 * (MPAD / 64); it += nw) {
        const int kb = it >> 1, which = it & 1, r = 64 * kb + which;
        if (kb >= 1 && r < MROWS) {
            const int b = r / LTOK, t = r - b * LTOK;
            const bf16_t* um2p = UH + ((size_t)(kb - 1) * 2 + (which ? 1 : 0)) * 1024 + lane * 16;
            const bf16_t* um1p = UH + ((size_t)(kb - 1) * 2 + 1) * 1024 + lane * 16;
            const bf16_t* gp = GH + ((size_t)kb * 2 + which) * 1024 + lane * 16;
            bf16_t* yp = ZG + (size_t)r * 2048 + 1024 + lane * 16;
            const float m2 = (t >= 2) ? 1.f : 0.f, m1 = (which == 0 && t >= 1) ? 1.f : 0.f;
#pragma unroll
            for (int hh = 0; hh < 2; ++hh) {
                const u32x4 a2 = *(const u32x4*)(um2p + 8 * hh), a1 = *(const u32x4*)(um1p + 8 * hh), gg = *(const u32x4*)(gp + 8 * hh), yy = *(const u32x4*)(yp + 8 * hh);
                u32x4 o;
#pragma unroll
                for (int q = 0; q < 4; ++q) {
                    const int e = 8 * hh + 2 * q;
                    const float c0 = bf_lo(gg[q]) * (m2 * cw[e] * bf_lo(a2[q]) + m1 * cw[1024 + e] * bf_lo(a1[q]));
                    const float c1 = bf_hi(gg[q]) * (m2 * cw[e + 1] * bf_hi(a2[q]) + m1 * cw[1024 + e + 1] * bf_hi(a1[q]));
                    o[q] = cvt_pk_bf16(bf_lo(yy[q]) + c0, bf_hi(yy[q]) + c1);
                }
                if (!dry) *(u32x4*)(yp + 8 * hh) = o;
            }
        }
    }
}

__device__ __forceinline__ void phase_final(const Params& p) {
    int tid = threadIdx.x; asm volatile("" : "+v"(tid));
    const int wid = tid >> 6, lane = tid & 63;
    const int gw = blockIdx.x * 8 + wid, nw = gridDim.x * 8;
    for (int r = gw; r < 8 * 4096; r += nw) {
        float* s = p.out + (size_t)r * 1024;
        f32x4 v[4]; float ss = 0.f;
#pragma unroll
        for (int q = 0; q < 4; ++q) { v[q] = *(const f32x4*)(s + lane * 4 + 256 * q); ss += v[q][0] * v[q][0] + v[q][1] * v[q][1] + v[q][2] * v[q][2] + v[q][3] * v[q][3]; }
#pragma unroll
        for (int o = 32; o >= 1; o >>= 1) ss += __shfl_xor(ss, o);
        const float rstd = rsqrtf(ss * (1.f / 1024.f) + EPS);
#pragma unroll
        for (int q = 0; q < 4; ++q) { const f32x4 gq = *(const f32x4*)(p.final_g + lane * 4 + 256 * q); *(f32x4*)(s + lane * 4 + 256 * q) = v[q] * rstd * gq; }
    }
}

#define XB_TMO      128
#define XB_XCNT(j)  (256  + 64 * (j))
#define XB_XSUB(j)  (1280 + 64 * (j))
#define XB_XGEN(j)  (2304 + 64 * (j))
#define XB_TOP      3328
#define XB_TOPGEN   3392
#define XCD_BAR_WORDS 3456
#define XB_SPIN_CAP (1u << 24)
__device__ __forceinline__ unsigned xb_ld(unsigned* p)              { return __hip_atomic_load(p, __ATOMIC_RELAXED, __HIP_MEMORY_SCOPE_AGENT); }
__device__ __forceinline__ unsigned xb_add(unsigned* p, unsigned v) { return __hip_atomic_fetch_add(p, v, __ATOMIC_RELAXED, __HIP_MEMORY_SCOPE_AGENT); }
__device__ __forceinline__ unsigned xb_xcc_id() { return (unsigned)__builtin_amdgcn_s_getreg((3 << 11) | 20) & 0xFu; }
#define XB_SPIN(cond, bar) do { unsigned _sp = 0; while (cond) { __builtin_amdgcn_s_sleep(1); \
    if ((++_sp & 255u) == 0u) { if (xb_ld(&(bar)[XB_TMO])) break; if (_sp > XB_SPIN_CAP) { atomicAdd(&(bar)[XB_TMO], 1u); break; } } } } while (0)
struct XcdBarrier { unsigned* bar; unsigned x; volatile LAS unsigned* st; };
__device__ __forceinline__ XcdBarrier xcd_barrier_post(unsigned* bar, volatile LAS unsigned* st) {
    XcdBarrier b; b.bar = bar; b.x = xb_xcc_id(); b.st = st;
    if (threadIdx.x == 0) (void)xb_add(&bar[XB_XCNT(b.x)], 1u);
    return b;
}
__device__ __forceinline__ void xcd_barrier_complete(unsigned* bar, unsigned x, unsigned& nloc, unsigned& nx) {
    const unsigned G = gridDim.x * gridDim.y * gridDim.z;
    unsigned sum, cnt, mine, sp = 0u;
    for (;;) {
        sum = 0u; cnt = 0u; mine = 0u;
#pragma unroll
        for (unsigned j = 0; j < 16; ++j) { const unsigned c = xb_ld(&bar[XB_XCNT(j)]); sum += c; cnt += (c > 0u) ? 1u : 0u; mine = (j == x) ? c : mine; }
        if (sum == G) break;
        __builtin_amdgcn_s_sleep(1);
        if ((++sp & 255u) == 0u) { if (xb_ld(&bar[XB_TMO])) break; if (sp > XB_SPIN_CAP) { atomicAdd(&bar[XB_TMO], 1u); break; } }
    }
    nloc = mine > 0u ? mine : 1u; nx = cnt > 0u ? cnt : 1u;
}
__device__ __forceinline__ void xcd_barrier(const XcdBarrier& b) {
    asm volatile("s_waitcnt vmcnt(0)" ::: "memory");
    __syncthreads();
    if (threadIdx.x == 0) {
        unsigned* bar = b.bar;
        __builtin_amdgcn_s_waitcnt(0);
        unsigned nloc = b.st[0], nx = b.st[1];
        if (nloc == 0u) { xcd_barrier_complete(bar, b.x, nloc, nx); b.st[0] = nloc; b.st[1] = nx; }
        const unsigned old = xb_add(&bar[XB_XSUB(b.x)], 1u);
        const unsigned gen = old / nloc;
        if (old + 1u == (gen + 1u) * nloc) {
            __builtin_amdgcn_fence(__ATOMIC_RELEASE, "agent");
            asm volatile("s_waitcnt vmcnt(0)" ::: "memory");
            const unsigned og = xb_add(&bar[XB_TOP], 1u);
            const unsigned tg = og / nx;
            if (og + 1u == (tg + 1u) * nx) xb_add(&bar[XB_TOPGEN], 1u);
            else XB_SPIN(xb_ld(&bar[XB_TOPGEN]) == tg, bar);
            __builtin_amdgcn_fence(__ATOMIC_ACQUIRE, "agent");
            xb_add(&bar[XB_XGEN(b.x)], 1u);
            asm volatile("s_waitcnt vmcnt(0)" ::: "memory");
        } else {
            XB_SPIN(xb_ld(&bar[XB_XGEN(b.x)]) == gen, bar);
            __builtin_amdgcn_fence(__ATOMIC_ACQUIRE, "agent");
            asm volatile("s_waitcnt vmcnt(0)" ::: "memory");
        }
    }
    __syncthreads();
}

constexpr int N_PHASES = 33;
#ifndef PHM
#define PHM 63
#endif

__global__ void __launch_bounds__(512, 2) mega(Params p) {
    extern __shared__ __attribute__((aligned(16))) unsigned char shm[];
    LAS unsigned char* lds = (LAS unsigned char*)shm;
#ifdef PROBE_SEL
    unsigned long long tprev = __builtin_amdgcn_s_memrealtime(); float tacc[8] = {0.f, 0.f, 0.f, 0.f, 0.f, 0.f, 0.f, 0.f};
#endif
    XcdBarrier xb; xb.bar = (unsigned*)(p.ws + OFF_BAR); xb.x = 0; xb.st = (volatile LAS unsigned*)(lds + LDS_BYTES - 16);
    if (p.ph_hi - p.ph_lo > 1) {
        if (threadIdx.x == 0) { xb.st[0] = 0u; xb.st[1] = 0u; }
        __syncthreads();
        xb = xcd_barrier_post((unsigned*)(p.ws + OFF_BAR), (volatile LAS unsigned*)(lds + LDS_BYTES - 16));
    }
    for (int ph = p.ph_lo; ph < p.ph_hi; ++ph) {
        if (ph == p.ph_lo + 1) cg::this_grid().sync();
        else if (ph > p.ph_lo) xcd_barrier(xb);
#ifdef PROBE_SEL
        if (ph > p.ph_lo) { const unsigned long long tn = __builtin_amdgcn_s_memrealtime(); const float d = (float)(tn - tprev) * 0.01f; tprev = tn; const int ps = (ph - 1) & 7;
#pragma unroll
            for (int q = 0; q < 8; ++q) if (q == ps) tacc[q] += d; }
#endif
        if (ph == 32) { phase_final(p);
#ifdef PROBE_SEL
            __syncthreads();
            if (blockIdx.x == 0 && threadIdx.x == 0) {
                float a, b;
                if (PROBE_SEL == 0) { a = tacc[2] + tacc[4]; b = tacc[3] + tacc[5]; }
                else if (PROBE_SEL == 1) { a = tacc[1]; b = tacc[7]; }
                else { a = tacc[0]; b = tacc[6]; }
                p.out[0] = a; p.out[1024] = b;
            }
#endif
            continue; }
        const int l = ph >> 3, s = ph & 7;
#ifdef DUPSEL
        if ((DUPSEL >> s) & 1) {
            if (s == 0) phase_prep(p, l);
            else if (s == 2 || s == 4) stage_a(p, l, s == 4 ? 1 : 0, lds, true);
            else if (s == 3 || s == 5) stage_b(p, s == 5 ? 1 : 0, lds, true);
            else if (s == 6) phase_mix(p, l, true);
            cg::this_grid().sync();
        }
#endif
        if (s == 0) { if (PHM & 1) phase_prep(p, l); }
        else if (s == 1) { if (PHM & 2) {
            pg8::Gemm g; g.A = (const bf16_t*)(p.ws + OFF_X); g.Bt = (const bf16_t*)(p.ws + OFF_WIN); g.M = MPAD; g.N = N1; g.K = 1024;
            pg8::StaticOrder<false> S; S.init(MPAD, N1, 1024, gridDim.x, blockIdx.x);
            Epi1 E; E.QKV = (bf16_t*)(p.ws + OFF_QKV); E.ZG = (bf16_t*)(p.ws + OFF_ZG); E.U = (bf16_t*)(p.ws + OFF_U); E.AB = (float*)(p.ws + OFF_AB); E.HALO = (bf16_t*)(p.ws + OFF_HALO);
            E.A_log = p.A_log + l * 8; E.dt_bias = p.dt_bias + l * 8; E.scw = p.sc_conv_w + (size_t)l * 3 * 1024;
            pg8::gemm_phase(lds, g, S, E); }
        }
        else if (s == 2 || s == 4) { if (PHM & 4) stage_a(p, l, s == 4 ? 1 : 0, lds); }
        else if (s == 3 || s == 5) { if (PHM & 8) stage_b(p, s == 5 ? 1 : 0, lds); }
        else if (s == 6) { if (PHM & 16) phase_mix(p, l); }
        else if (PHM & 32) {
            pg8::Gemm g; g.A = (const bf16_t*)(p.ws + OFF_ZG); g.Bt = (const bf16_t*)(p.ws + OFF_WOUT); g.M = MPAD; g.N = 1024; g.K = 2048;
            pg8::StaticOrder<true> S; S.init(MPAD - 256, 1024, 2048, gridDim.x, blockIdx.x);
            Epi2 E; E.src_real = (l == 0) ? p.x : (const float*)p.out; E.src_meta = (l == 0) ? p.meta : (const float*)(p.ws + OFF_HMETA); E.meta_bstride = (l == 0) ? 0 : 16;
            E.dst_real = p.out; E.dst_meta = (float*)(p.ws + OFF_HMETA);
            pg8::gemm_phase(lds, g, S, E);
        }
    }
}

extern "C" void kernel_launch(void* const* d_in, const int* in_sizes, int n_in, void* d_out, int out_size, void* d_ws, size_t ws_size, hipStream_t stream) {
    static int grid = 0;
    if (grid == 0) {
        if (n_in != 11 || ws_size < WS_END2) { fprintf(stderr, "kernel_launch: bad inputs / workspace (%zu < %zu)\n", ws_size, (size_t)WS_END2); grid = -1; return; }
        int dev = 0, cus = 0, per_cu = 0;
        hipGetDevice(&dev);
        hipDeviceGetAttribute(&cus, hipDeviceAttributeMultiprocessorCount, dev);
        hipFuncSetAttribute((const void*)mega, hipFuncAttributeMaxDynamicSharedMemorySize, LDS_BYTES);
        hipOccupancyMaxActiveBlocksPerMultiprocessor(&per_cu, (const void*)mega, 512, LDS_BYTES);
        if (per_cu < 1) per_cu = 1;
        if (per_cu > 1) per_cu = 1;
        grid = cus * per_cu;
        (void)hipGetLastError();
    }
    if (grid < 0) return;
    Params p{};
    p.x = (const float*)d_in[0]; p.meta = (const float*)d_in[1]; p.norm_g = (const float*)d_in[2]; p.w_in = (const float*)d_in[3]; p.dn_conv_w = (const float*)d_in[4];
    p.A_log = (const float*)d_in[5]; p.dt_bias = (const float*)d_in[6]; p.out_g = (const float*)d_in[7]; p.sc_conv_w = (const float*)d_in[8]; p.w_out = (const float*)d_in[9]; p.final_g = (const float*)d_in[10];
    p.out = (float*)d_out; p.ws = (unsigned char*)d_ws;
#if N_LAUNCH_MODE == 1
    for (int ph = 0; ph < N_PHASES; ++ph) {
        p.ph_lo = ph; p.ph_hi = ph + 1;
        hipLaunchKernelGGL(mega, dim3(grid), dim3(512), LDS_BYTES, stream, p);
    }
#else
    p.ph_lo = 0; p.ph_hi = N_PHASES;
    (void)hipMemsetAsync((unsigned char*)d_ws + OFF_BAR, 0, XCD_BAR_WORDS * 4, stream);
    void* args[] = {&p};
    hipError_t e = hipLaunchCooperativeKernel((const void*)mega, dim3(grid), dim3(512), args, LDS_BYTES, stream);
    if (e != hipSuccess) fprintf(stderr, "cooperative launch failed: %s (grid %d)\n", hipGetErrorString(e), grid);
#endif
}
```
